# Optimizing an MI355X kernel written in HIP

```python
import jax, jax.numpy as jnp
from jax import lax
import numpy as np

D_MODEL = 1024
BATCH = 16
SEQ = 4096
DEPTH = 1

HEAD_DIM = 64
N_HEADS_SB = 8
N_HEADS_FOX = 8
D_SB = N_HEADS_SB * HEAD_DIM
D_FOX = N_HEADS_FOX * HEAD_DIM
D_FF = -(-8 * D_MODEL // (3 * 256)) * 256
Q_BLOCK = 128
RMS_EPS = 1e-6
N_MOD = 6
FORGET_BIAS_INIT = 3.0
IN_SPLITS = (D_SB, 2 * D_SB, 3 * D_SB,
             3 * D_SB + D_FOX, 3 * D_SB + 2 * D_FOX, 3 * D_SB + 3 * D_FOX,
             3 * D_SB + 3 * D_FOX + N_HEADS_FOX,
             3 * D_SB + 3 * D_FOX + N_HEADS_FOX + D_MODEL)
D_IN_PROJ = 3 * D_SB + 3 * D_FOX + N_HEADS_FOX + 2 * D_MODEL

kernel_name = 'hybrid_stickbreak_fox_gated_block'


def rms_norm(x, g):
    xf = x.astype(jnp.float32)
    y = xf * lax.rsqrt(jnp.mean(xf * xf, axis=-1, keepdims=True) + RMS_EPS)
    return (y * g.astype(jnp.float32)).astype(x.dtype)


def to_blocks(t):
    b, s, h, d = t.shape
    return t.reshape(b, s // Q_BLOCK, Q_BLOCK, h, d).transpose(1, 0, 3, 2, 4)


def from_blocks(t):
    nb, b, h, q, d = t.shape
    return t.transpose(1, 0, 3, 2, 4).reshape(b, nb * q, h * d)


def stick_breaking_attention(q, k, v):
    s = q.shape[1]
    nb = s // Q_BLOCK
    kh = k.transpose(0, 2, 1, 3).astype(jnp.float32)
    vh = v.transpose(0, 2, 1, 3).astype(jnp.float32)
    key_pos = jnp.arange(s, dtype=jnp.int32)
    scale = HEAD_DIM ** -0.5

    def block(args):
        q_blk, start = args
        z = jnp.einsum('bhqd,bhkd->bhqk', q_blk.astype(jnp.float32), kh) * scale
        q_pos = start + jnp.arange(Q_BLOCK, dtype=jnp.int32)
        past = key_pos[None, :] < q_pos[:, None]
        log_keep = jnp.where(past, jax.nn.log_sigmoid(-z), 0.0)
        after = lax.cumsum(log_keep, axis=3, reverse=True) - log_keep
        w = jnp.where(past, jnp.exp(jax.nn.log_sigmoid(z) + after), 0.0)
        return jnp.einsum('bhqk,bhkd->bhqd', w, vh)

    starts = jnp.arange(nb, dtype=jnp.int32) * Q_BLOCK
    out = lax.map(block, (to_blocks(q), starts))
    return from_blocks(out).astype(q.dtype)


def forgetting_attention(q, k, v, log_f):
    b, s, h, _ = q.shape
    nb = s // Q_BLOCK
    cum = jnp.cumsum(log_f.astype(jnp.float32), axis=1)
    cum_k = cum.transpose(0, 2, 1)
    cum_q = cum.reshape(b, nb, Q_BLOCK, h).transpose(1, 0, 3, 2)
    kh = k.transpose(0, 2, 1, 3).astype(jnp.float32)
    vh = v.transpose(0, 2, 1, 3).astype(jnp.float32)
    key_pos = jnp.arange(s, dtype=jnp.int32)
    scale = HEAD_DIM ** -0.5

    def block(args):
        q_blk, cq, start = args
        logits = jnp.einsum('bhqd,bhkd->bhqk', q_blk.astype(jnp.float32), kh) * scale
        logits = logits + cq[..., :, None] - cum_k[:, :, None, :]
        q_pos = start + jnp.arange(Q_BLOCK, dtype=jnp.int32)
        causal = key_pos[None, :] <= q_pos[:, None]
        p = jax.nn.softmax(jnp.where(causal, logits, -jnp.inf), axis=-1)
        return jnp.einsum('bhqk,bhkd->bhqd', p, vh)

    starts = jnp.arange(nb, dtype=jnp.int32) * Q_BLOCK
    out = lax.map(block, (to_blocks(q), cum_q, starts))
    return from_blocks(out).astype(q.dtype)


def setup_inputs(seed: int = 0) -> dict:
    key = jax.random.key(seed)
    ks = jax.random.split(key, 17)
    f32 = jnp.float32

    def nrm(k, shape, fan_in):
        return jax.random.normal(k, shape, f32) * fan_in ** -0.5

    def gain(k, shape):
        return 1.0 + 0.05 * jax.random.normal(k, shape, f32)

    return {
        'x': jax.random.normal(ks[0], (BATCH, SEQ, D_MODEL), f32),
        'c': jax.random.normal(ks[1], (BATCH, D_MODEL), f32),
        'w_ada': nrm(ks[2], (DEPTH, D_MODEL, N_MOD * D_MODEL), D_MODEL),
        'b_ada': 0.02 * jax.random.normal(ks[3], (DEPTH, N_MOD * D_MODEL), f32),
        'g_mix': gain(ks[4], (DEPTH, D_MODEL)),
        'w_in': nrm(ks[5], (DEPTH, D_MODEL, D_IN_PROJ), D_MODEL),
        'b_forget': FORGET_BIAS_INIT + 0.1 * jax.random.normal(ks[6], (DEPTH, N_HEADS_FOX), f32),
        'b_gate': 0.02 * jax.random.normal(ks[7], (DEPTH, 2 * D_MODEL), f32),
        'w_branch_sb': nrm(ks[8], (DEPTH, D_SB, D_MODEL), D_SB),
        'w_branch_fox': nrm(ks[9], (DEPTH, D_FOX, D_MODEL), D_FOX),
        'w_out': nrm(ks[10], (DEPTH, D_MODEL, D_MODEL), D_MODEL),
        'g_ffn': gain(ks[11], (DEPTH, D_MODEL)),
        'w_ffn_gate': nrm(ks[12], (DEPTH, D_MODEL, D_FF), D_MODEL),
        'w_ffn_up': nrm(ks[13], (DEPTH, D_MODEL, D_FF), D_MODEL),
        'w_ffn_down': nrm(ks[14], (DEPTH, D_FF, D_MODEL), D_FF),
        'g_final': gain(ks[15], (D_MODEL,)),
    }


def reference(x, c, w_ada, b_ada, g_mix, w_in, b_forget, b_gate, w_branch_sb, w_branch_fox,
              w_out, g_ffn, w_ffn_gate, w_ffn_up, w_ffn_down, g_final):
    b, s, _ = x.shape
    c_act = jax.nn.silu(c)
    for l in range(DEPTH):
        mod = c_act @ w_ada[l] + b_ada[l]
        shift1, scale1, gate1, shift2, scale2, gate2 = [m[:, None, :] for m in jnp.split(mod, N_MOD, axis=-1)]

        h = rms_norm(x, g_mix[l]) * (1.0 + scale1) + shift1
        proj = h @ w_in[l]
        q_sb, k_sb, v_sb, q_fx, k_fx, v_fx, f_logit, gl_sb, gl_fx = jnp.split(proj, IN_SPLITS, axis=-1)
        heads_sb = lambda t: t.reshape(b, s, N_HEADS_SB, HEAD_DIM)
        heads_fx = lambda t: t.reshape(b, s, N_HEADS_FOX, HEAD_DIM)

        y_sb = stick_breaking_attention(heads_sb(q_sb), heads_sb(k_sb), heads_sb(v_sb))
        log_f = jax.nn.log_sigmoid(f_logit.astype(jnp.float32) + b_forget[l])
        y_fx = forgetting_attention(heads_fx(q_fx), heads_fx(k_fx), heads_fx(v_fx), log_f)

        gates = jax.nn.sigmoid(jnp.concatenate([gl_sb, gl_fx], axis=-1) + b_gate[l])
        g_sb, g_fx = jnp.split(gates, 2, axis=-1)
        merged = g_sb * (y_sb @ w_branch_sb[l]) + g_fx * (y_fx @ w_branch_fox[l])
        x = x + gate1 * (merged @ w_out[l])

        h2 = rms_norm(x, g_ffn[l]) * (1.0 + scale2) + shift2
        ffn = (jax.nn.silu(h2 @ w_ffn_gate[l]) * (h2 @ w_ffn_up[l])) @ w_ffn_down[l]
        x = x + gate2 * ffn
    return rms_norm(x, g_final)
```

```cpp
#include <hip/hip_runtime.h>
#include <hip/hip_cooperative_groups.h>
#include <cstdio>
#include <cstdint>
namespace cg = cooperative_groups;
namespace pg8 {
#define PG8_LAS __attribute__((address_space(3)))
typedef unsigned short bf16_t;
typedef short bf16x8 __attribute__((ext_vector_type(8)));
typedef float f32x4 __attribute__((ext_vector_type(4)));
typedef unsigned u32x4 __attribute__((ext_vector_type(4)));
constexpr int BM = 256, BK = 64, HALF = 128, HTB = HALF * BK * 2  , STAGE_BYTES = 8 * HTB, NXCD = 8, WGM = 8;

__host__ __device__ __forceinline__ int lds_byte(int r, int c) { const int st = (r >> 4) * 2 + (c >> 5), rr = r & 15, cc = c & 31, ob = rr * 64 + cc * 2; return st * 1024 + (ob ^ (((ob >> 9) & 1) << 5)); }
__host__ __device__ __forceinline__ void stage_rc(int b, int& R, int& C) { const int st = b / 1024, sb = b % 1024, swz = sb ^ (((sb >> 9) & 1) << 5); R = (st >> 1) * 16 + swz / 64; C = (st & 1) * 32 + (swz % 64) / 2; }
__host__ __device__ __forceinline__ int perm32(int rho) { const int n = rho >> 4, i = rho & 15; return 8 * (i >> 2) + 4 * n + (i & 3); }

struct Unit { int pm, pn; };
struct Gemm { const bf16_t* A; const bf16_t* Bt; int M, N, K; };

struct StaticOrder {
    int nM, nN, nwg, G, c;
    __host__ __device__ void init(int M, int N, int G_, int c_) { nM = M / BM; nN = N / BM; nwg = nM * nN; G = G_; c = c_; }
    __host__ __device__ bool next(int i, Unit& u) const {
        const long L = (long)i * G + c; if (L >= nwg) return false;
        int wgid = (int)L; { const int q = nwg / NXCD, r = nwg % NXCD, xcd = wgid % NXCD, off = wgid / NXCD; wgid = (xcd < r ? xcd * (q + 1) : r * (q + 1) + (xcd - r) * q) + off; }
        const int nig = WGM * nN, gid = wgid / nig, fm = gid * WGM, gsz = (nM - fm) < WGM ? (nM - fm) : WGM;
        u.pm = fm + ((wgid % nig) % gsz); u.pn = (wgid % nig) / gsz; return true;
    }
    __device__ __forceinline__ void a_ready(const Unit&) const {}
    __device__ __forceinline__ void done(const Unit&) const {}
};

typedef float f32x2_cv __attribute__((ext_vector_type(2))); typedef __bf16 bf16x2_cv __attribute__((ext_vector_type(2)));
__device__ __forceinline__ unsigned cvt_pk_bf16(float lo, float hi) { f32x2_cv v = {lo, hi}; bf16x2_cv b = __builtin_convertvector(v, bf16x2_cv); return __builtin_bit_cast(unsigned, b); }
typedef unsigned u32x2 __attribute__((ext_vector_type(2)));
__device__ __forceinline__ float bf_lo(unsigned w) { return __uint_as_float(w << 16); }
__device__ __forceinline__ float bf_hi(unsigned w) { return __uint_as_float(w & 0xffff0000u); }
__device__ __forceinline__ float fast_sigmoid(float x) { return __builtin_amdgcn_rcpf(1.f + __builtin_amdgcn_exp2f(-1.4426950409f * x)); }
__device__ __forceinline__ u32x4 pack8(f32x4 v0, f32x4 v1) { u32x4 w; w.x = cvt_pk_bf16(v0[0], v0[1]); w.y = cvt_pk_bf16(v0[2], v0[3]); w.z = cvt_pk_bf16(v1[0], v1[1]); w.w = cvt_pk_bf16(v1[2], v1[3]); return w; }

struct EpiIn {
    static constexpr bool PERM = true, AFTER_DRAIN = false;
    bf16_t* qkv; bf16_t* gates; const float* b_gate; float qscale;
    __device__ __forceinline__ void operator()(const f32x4 (&acc)[2][2][4][2], const Unit& u, int wr, int wc, int fr, int fq) const {
        const int row0 = u.pm * BM + wr * 64 + fr;
        if (u.pn < 12) {
            const float sc = (u.pn < 2 || (u.pn >= 6 && u.pn < 8)) ? qscale : 1.f;
            const int col0 = u.pn * BM + wc * 32 + 8 * fq;
#pragma unroll
            for (int ai = 0; ai < 2; ++ai)
#pragma unroll
                for (int m = 0; m < 4; ++m) { bf16_t* rowp = qkv + (size_t)(row0 + ai * HALF + m * 16) * 3072 + col0;
#pragma unroll
                    for (int bj = 0; bj < 2; ++bj) *(u32x4*)(rowp + bj * HALF) = pack8(acc[ai][bj][m][0] * sc, acc[ai][bj][m][1] * sc); }
        } else {
            const int col0 = (u.pn - 12) * BM + wc * 32 + 8 * fq;
            f32x4 bv[2][2];
#pragma unroll
            for (int bj = 0; bj < 2; ++bj)
#pragma unroll
                for (int n = 0; n < 2; ++n) bv[bj][n] = *(const f32x4*)(b_gate + col0 + bj * HALF + 4 * n);
#pragma unroll
            for (int ai = 0; ai < 2; ++ai)
#pragma unroll
                for (int m = 0; m < 4; ++m) { bf16_t* rowp = gates + (size_t)(row0 + ai * HALF + m * 16) * 2048 + col0;
#pragma unroll
                    for (int bj = 0; bj < 2; ++bj) { f32x4 v0 = acc[ai][bj][m][0] + bv[bj][0], v1 = acc[ai][bj][m][1] + bv[bj][1];
#ifndef DBG_NOSIG
#pragma unroll
                        for (int e = 0; e < 4; ++e) { v0[e] = fast_sigmoid(v0[e]); v1[e] = fast_sigmoid(v1[e]); }
#endif
                        *(u32x4*)(rowp + bj * HALF) = pack8(v0, v1); } }
        }
    }
};
template <bool FIRST> struct EpiBranch {
    static constexpr bool PERM = true, AFTER_DRAIN = false;
    bf16_t* merged; const bf16_t* gates; int goff;
    __device__ __forceinline__ void operator()(const f32x4 (&acc)[2][2][4][2], const Unit& u, int wr, int wc, int fr, int fq) const {
        const int row0 = u.pm * BM + wr * 64 + fr, col0 = u.pn * BM + wc * 32 + 8 * fq;
#pragma unroll
        for (int ai = 0; ai < 2; ++ai)
#pragma unroll
            for (int m = 0; m < 4; ++m) { const size_t row = (size_t)(row0 + ai * HALF + m * 16);
#pragma unroll
                for (int bj = 0; bj < 2; ++bj) { const int c = col0 + bj * HALF;
                    const u32x4 gw = *(const u32x4*)(gates + row * 2048 + goff + c);
                    f32x4 g0 = {bf_lo(gw.x), bf_hi(gw.x), bf_lo(gw.y), bf_hi(gw.y)}, g1 = {bf_lo(gw.z), bf_hi(gw.z), bf_lo(gw.w), bf_hi(gw.w)};
                    f32x4 v0 = g0 * acc[ai][bj][m][0], v1 = g1 * acc[ai][bj][m][1];
                    if (!FIRST) { const u32x4 pw = *(const u32x4*)(merged + row * 1024 + c);
                        v0 += (f32x4){bf_lo(pw.x), bf_hi(pw.x), bf_lo(pw.y), bf_hi(pw.y)}; v1 += (f32x4){bf_lo(pw.z), bf_hi(pw.z), bf_lo(pw.w), bf_hi(pw.w)}; }
                    *(u32x4*)(merged + row * 1024 + c) = pack8(v0, v1); } }
    }
};
struct EpiResid {
    static constexpr bool PERM = false, AFTER_DRAIN = false;
    const float* base; float* out; const float* gate;
    __device__ __forceinline__ void operator()(const f32x4 (&acc)[2][2][4][2], const Unit& u, int wr, int wc, int fr, int fq) const {
        const int row0 = u.pm * BM + wr * 64 + fr, col0 = u.pn * BM + wc * 32 + 4 * fq, b = (u.pm * BM) >> 12;
        f32x4 gv[2][2];
#pragma unroll
        for (int bj = 0; bj < 2; ++bj)
#pragma unroll
            for (int n = 0; n < 2; ++n) gv[bj][n] = *(const f32x4*)(gate + (size_t)b * 6144 + col0 + bj * HALF + n * 16);
#pragma unroll
        for (int ai = 0; ai < 2; ++ai)
#pragma unroll
            for (int m = 0; m < 4; ++m) { const size_t off = (size_t)(row0 + ai * HALF + m * 16) * 1024 + col0;
#pragma unroll
                for (int bj = 0; bj < 2; ++bj)
#pragma unroll
                    for (int n = 0; n < 2; ++n) { const f32x4 bs = *(const f32x4*)(base + off + bj * HALF + n * 16);
                        *(f32x4*)(out + off + bj * HALF + n * 16) = bs + gv[bj][n] * acc[ai][bj][m][n]; } }
    }
};
struct EpiSwiglu {
    static constexpr bool PERM = true, AFTER_DRAIN = false;
    bf16_t* A;
    __device__ __forceinline__ void operator()(const f32x4 (&acc)[2][2][4][2], const Unit& u, int wr, int wc, int fr, int fq) const {
        const int row0 = u.pm * BM + wr * 64 + fr, col0 = u.pn * HALF + wc * 32 + 8 * fq;
#pragma unroll
        for (int ai = 0; ai < 2; ++ai)
#pragma unroll
            for (int m = 0; m < 4; ++m) { bf16_t* rowp = A + (size_t)(row0 + ai * HALF + m * 16) * 2816 + col0;
                f32x4 r0, r1;
#pragma unroll
                for (int e = 0; e < 4; ++e) { const float g0 = acc[ai][0][m][0][e], g1 = acc[ai][0][m][1][e];
                    r0[e] = g0 * fast_sigmoid(g0) * acc[ai][1][m][0][e]; r1[e] = g1 * fast_sigmoid(g1) * acc[ai][1][m][1][e]; }
                *(u32x4*)rowp = pack8(r0, r1); }
    }
};

template <class Epi, class Sched, bool ALIGN_EPI = false, bool SP2 = false>
__device__ __forceinline__ void gemm_phase(PG8_LAS unsigned char* lds, const Gemm g, const Sched& S, const Epi& E) {
    const int tid = threadIdx.x, wid = __builtin_amdgcn_readfirstlane(tid >> 6), lane = tid & 63, wr = wid >> 2, wc = wid & 3, fr = lane & 15, fq = lane >> 4;
    const int K = g.K, nt = K / BK;
    unsigned voffA[2], voffB[2];
#pragma unroll
    for (int i = 0; i < 2; ++i) { int R, C; stage_rc(tid * 16 + i * 8192, R, C); const int Rb = Epi::PERM ? ((R & ~31) + perm32(R & 31)) : R;
        voffA[i] = (unsigned)(R * K + C) * 2u; voffB[i] = (unsigned)(Rb * K + C) * 2u; }
    const size_t kstep = (size_t)(BK * 2);
    const size_t hstep = (size_t)HALF * K * 2;
    const size_t tstep = 2 * hstep;
    const unsigned ldsw = (unsigned)wid * 1024u;
    const int aoff = lds_byte(wr * 64 + fr, fq * 8), boff = lds_byte(wc * 32 + fr, fq * 8);
#define PG8_SA(b, h) (((b) * 2 + (h)) * HTB)
#define PG8_SB(b, h) ((4 + (b) * 2 + (h)) * HTB)
#define PG8_STAGE(bufoff, gbase, voff) do { _Pragma("unroll") for (int _i = 0; _i < 2; ++_i) \
        __builtin_amdgcn_global_load_lds((const unsigned*)((const char*)(gbase) + (voff)[_i]), (PG8_LAS unsigned*)(lds + (bufoff) + ldsw + _i * 8192), 16, 0, 0); } while (0)
#define PG8_LDA(dst, b, h) do { _Pragma("unroll") for (int m = 0; m < 4; ++m) _Pragma("unroll") for (int k = 0; k < 2; ++k) dst[m][k] = *(const PG8_LAS bf16x8*)(lds + PG8_SA(b, h) + aoff + m * 2048 + k * 1024); } while (0)
#define PG8_LDB(dst, b, h) do { _Pragma("unroll") for (int n = 0; n < 2; ++n) _Pragma("unroll") for (int k = 0; k < 2; ++k) dst[n][k] = *(const PG8_LAS bf16x8*)(lds + PG8_SB(b, h) + boff + n * 2048 + k * 1024); } while (0)
#define PG8_MMA(ai, bj, At, Bt) do { __builtin_amdgcn_s_setprio(1); _Pragma("unroll") for (int m = 0; m < 4; ++m) _Pragma("unroll") for (int n = 0; n < 2; ++n) _Pragma("unroll") for (int k = 0; k < 2; ++k) \
        acc[ai][bj][m][n] = __builtin_amdgcn_mfma_f32_16x16x32_bf16(Bt[n][k], At[m][k], acc[ai][bj][m][n], 0, 0, 0); __builtin_amdgcn_s_setprio(0); } while (0)
#define PG8_WAIT_V(n) asm volatile("s_waitcnt vmcnt(" #n ")" ::: "memory")
#define PG8_WAIT_L(n) asm volatile("s_waitcnt lgkmcnt(" #n ")" ::: "memory")
#define PG8_BAR __builtin_amdgcn_s_barrier()
#define PG8_SCHED __builtin_amdgcn_sched_barrier(0)
    Unit cur, nxt; int ui = 0;
    if (!S.next(0, cur)) return;
    f32x4 acc[2][2][4][2];
#pragma unroll
    for (int a = 0; a < 2; ++a)
#pragma unroll
        for (int b = 0; b < 2; ++b)
#pragma unroll
            for (int m = 0; m < 4; ++m)
#pragma unroll
                for (int n = 0; n < 2; ++n) acc[a][b][m][n] = (f32x4){0.f, 0.f, 0.f, 0.f};
    bf16x8 At[4][2], B0[2][2], B1[2][2];
    const char* cA = (const char*)g.A + (size_t)cur.pm * tstep; const char* cB = (const char*)g.Bt + (size_t)cur.pn * tstep;
    S.a_ready(cur);
    if constexpr (SP2) {
        PG8_STAGE(PG8_SB(0, 0), cB, voffB); PG8_STAGE(PG8_SB(0, 1), cB + hstep, voffB); PG8_STAGE(PG8_SA(0, 0), cA, voffA); PG8_STAGE(PG8_SA(0, 1), cA + hstep, voffA);
        if (wr == 1) PG8_BAR;
        PG8_WAIT_V(2); PG8_BAR;
        PG8_STAGE(PG8_SB(1, 0), cB + kstep, voffB); PG8_STAGE(PG8_SA(1, 0), cA + kstep, voffA); PG8_STAGE(PG8_SB(1, 1), cB + hstep + kstep, voffB);
        PG8_WAIT_V(6); PG8_BAR;
    } else {
        PG8_STAGE(PG8_SB(0, 0), cB, voffB); PG8_STAGE(PG8_SA(0, 0), cA, voffA); PG8_STAGE(PG8_SB(0, 1), cB + hstep, voffB); PG8_STAGE(PG8_SA(0, 1), cA + hstep, voffA);
        if (wr == 1) PG8_BAR;
        PG8_WAIT_V(4); PG8_BAR;
        PG8_STAGE(PG8_SB(1, 0), cB + kstep, voffB); PG8_STAGE(PG8_SA(1, 0), cA + kstep, voffA); PG8_STAGE(PG8_SB(1, 1), cB + hstep + kstep, voffB);
        PG8_WAIT_V(6); PG8_BAR;
    }
    for (;;) {
        const bool has_next = S.next(ui + 1, nxt);
        const char* nA = has_next ? (const char*)g.A + (size_t)nxt.pm * tstep : cA; const char* nB = has_next ? (const char*)g.Bt + (size_t)nxt.pn * tstep : cB;
        for (int t = 0; t < nt; t += 2) {
            const bool last = (t == nt - 2);
            const char* a1 = cA + (size_t)(t + 1) * kstep;
            const char* a2 = last ? nA : cA + (size_t)(t + 2) * kstep; const char* b2 = last ? nB : cB + (size_t)(t + 2) * kstep;
            const char* a3 = a2 + kstep; const char* b3 = b2 + kstep;
            if (last && has_next) S.a_ready(nxt);
            if constexpr (SP2) {
            PG8_LDB(B0, 0, 0); PG8_LDB(B1, 0, 1); PG8_SCHED; PG8_LDA(At, 0, 0); PG8_STAGE(PG8_SA(1, 1), a1 + hstep, voffA);
            PG8_WAIT_V(8); PG8_WAIT_L(0); PG8_BAR; PG8_MMA(0, 0, At, B0); PG8_MMA(0, 1, At, B1); PG8_BAR; PG8_SCHED;
            PG8_LDA(At, 0, 1); PG8_STAGE(PG8_SB(0, 0), b2, voffB); PG8_STAGE(PG8_SB(0, 1), b2 + hstep, voffB); PG8_STAGE(PG8_SA(0, 0), a2, voffA);
            PG8_WAIT_V(8); PG8_WAIT_L(0); PG8_BAR; PG8_MMA(1, 0, At, B0); PG8_MMA(1, 1, At, B1); PG8_BAR; PG8_SCHED;
            PG8_LDB(B0, 1, 0); PG8_LDB(B1, 1, 1); PG8_SCHED; PG8_LDA(At, 1, 0); PG8_STAGE(PG8_SA(0, 1), a2 + hstep, voffA);
            PG8_WAIT_V(8); PG8_WAIT_L(0); PG8_BAR; PG8_MMA(0, 0, At, B0); PG8_MMA(0, 1, At, B1); PG8_BAR; PG8_SCHED;
            PG8_LDA(At, 1, 1); PG8_STAGE(PG8_SB(1, 0), b3, voffB); PG8_STAGE(PG8_SB(1, 1), b3 + hstep, voffB); PG8_STAGE(PG8_SA(1, 0), a3, voffA);
            PG8_WAIT_V(8); PG8_WAIT_L(0); PG8_BAR; PG8_MMA(1, 0, At, B0); PG8_MMA(1, 1, At, B1); PG8_BAR; PG8_SCHED;
            } else {
            PG8_LDB(B0, 0, 0); PG8_SCHED; PG8_LDA(At, 0, 0); PG8_STAGE(PG8_SA(1, 1), a1 + hstep, voffA);
            PG8_WAIT_L(8); PG8_BAR; PG8_WAIT_L(0); PG8_MMA(0, 0, At, B0); PG8_BAR; PG8_SCHED;
            PG8_LDB(B1, 0, 1); PG8_STAGE(PG8_SB(0, 0), b2, voffB);
            PG8_BAR; PG8_WAIT_L(0); PG8_MMA(0, 1, At, B1); PG8_BAR;
            PG8_LDA(At, 0, 1); PG8_STAGE(PG8_SA(0, 0), a2, voffA);
            PG8_BAR; PG8_WAIT_L(0); PG8_MMA(1, 0, At, B0); PG8_BAR; PG8_SCHED;
            PG8_STAGE(PG8_SB(0, 1), b2 + hstep, voffB);
            PG8_WAIT_V(6); PG8_BAR; PG8_MMA(1, 1, At, B1); PG8_BAR;
            PG8_LDB(B0, 1, 0); PG8_SCHED; PG8_LDA(At, 1, 0); PG8_STAGE(PG8_SA(0, 1), a2 + hstep, voffA);
            PG8_WAIT_L(8); PG8_BAR; PG8_WAIT_L(0); PG8_MMA(0, 0, At, B0); PG8_BAR; PG8_SCHED;
            PG8_LDB(B1, 1, 1); PG8_STAGE(PG8_SB(1, 0), b3, voffB);
            PG8_BAR; PG8_WAIT_L(0); PG8_MMA(0, 1, At, B1); PG8_BAR;
            PG8_LDA(At, 1, 1); PG8_STAGE(PG8_SA(1, 0), a3, voffA);
            PG8_BAR; PG8_WAIT_L(0); PG8_MMA(1, 0, At, B0); PG8_BAR; PG8_SCHED;
            PG8_STAGE(PG8_SB(1, 1), b3 + hstep, voffB);
            PG8_WAIT_V(6); PG8_BAR; PG8_MMA(1, 1, At, B1); PG8_BAR;
            }
        }
        if constexpr (ALIGN_EPI) { if (wr == 0) PG8_BAR; }
        if constexpr (!Epi::AFTER_DRAIN) { E(acc, cur, wr, wc, fr, fq); S.done(cur); }
        if (!has_next) break;
#pragma unroll
        for (int a = 0; a < 2; ++a)
#pragma unroll
            for (int b = 0; b < 2; ++b)
#pragma unroll
                for (int m = 0; m < 4; ++m)
#pragma unroll
                    for (int n = 0; n < 2; ++n) acc[a][b][m][n] = (f32x4){0.f, 0.f, 0.f, 0.f};
        cur = nxt; cA = nA; cB = nB; ++ui;
        if constexpr (ALIGN_EPI) { if (wr == 1) PG8_BAR; }
    }
    PG8_WAIT_V(0);
    if constexpr (!ALIGN_EPI) { if (wr == 0) PG8_BAR; }
    PG8_BAR;
    if constexpr (Epi::AFTER_DRAIN) { E.fused(acc, cur, wr, wc, fr, fq, lds, wid, lane); S.done(cur); }
#undef PG8_SA
#undef PG8_SB
#undef PG8_STAGE
#undef PG8_LDA
#undef PG8_LDB
#undef PG8_MMA
#undef PG8_WAIT_V
#undef PG8_WAIT_L
#undef PG8_BAR
#undef PG8_SCHED
}
}

namespace att {
typedef unsigned short bf16_t;
typedef short bf16x8 __attribute__((ext_vector_type(8)));
typedef short s16x4 __attribute__((ext_vector_type(4)));
typedef float f32x16 __attribute__((ext_vector_type(16)));
typedef float f32x4 __attribute__((ext_vector_type(4)));
typedef unsigned u32x4 __attribute__((ext_vector_type(4)));
typedef unsigned u32x2 __attribute__((ext_vector_type(2)));
#define ALAS __attribute__((address_space(3)))
constexpr int SEQ = 4096, PITCH = 3072, SLOTB = 8192;
constexpr int L_K = 0, L_V = 2 * SLOTB, L_CK = 4 * SLOTB, L_FLAG = L_CK + 16384, L_END = L_FLAG + 64;
constexpr float LOG2E = 1.4426950408889634f;
constexpr float SB_DONE = -160.f;
__device__ __forceinline__ int crow(int r, int hi) { return (r & 3) + 8 * (r >> 2) + 4 * hi; }
__device__ __forceinline__ void glds16(const void* gsrc, unsigned lds_dst) { unsigned keep;
    asm volatile("s_mov_b32 %0, m0\n\ts_mov_b32 m0, %2\n\ts_nop 0\n\tglobal_load_lds_dwordx4 %1, off\n\ts_mov_b32 m0, %0" : "=&s"(keep) : "v"(gsrc), "s"(lds_dst) : "memory"); }
typedef float f32x2_t __attribute__((ext_vector_type(2))); typedef __bf16 bf16x2_t __attribute__((ext_vector_type(2)));
__device__ __forceinline__ unsigned cvtpk(float lo, float hi) { f32x2_t v = {lo, hi}; bf16x2_t b = __builtin_convertvector(v, bf16x2_t); return __builtin_bit_cast(unsigned, b); }
typedef short v4i16_t __attribute__((ext_vector_type(4)));
__device__ __forceinline__ s16x4 vtr(const ALAS unsigned char* p) { return __builtin_bit_cast(s16x4, __builtin_amdgcn_ds_read_tr16_b64_v4i16((ALAS v4i16_t*)p)); }
#define ATT_WAIT_BAR(N) asm volatile("s_waitcnt vmcnt(" #N ") lgkmcnt(0)\n\ts_barrier" ::: "memory")
#define ATT_BAR() asm volatile("s_waitcnt lgkmcnt(0)\n\ts_barrier" ::: "memory")

template <bool SB>
__device__ __forceinline__ void attn_unit(int b, int h, int qb, const bf16_t* Q, const bf16_t* K, const bf16_t* V, const float* cum, bf16_t* O, ALAS unsigned char* shm) {
    const int tid = threadIdx.x, lane = tid & 63, r32 = lane & 31, hi = lane >> 5;
    const int wid = __builtin_amdgcn_readfirstlane(tid >> 6);
    const long rowbase = (long)b * SEQ; const int q0 = qb * 256;
    const int wq0 = q0 + wid * 32, qrow = wq0 + r32;
    const unsigned lds0 = (unsigned)(uintptr_t)shm;
    ALAS float* ck = (ALAS float*)(shm + L_CK);
    ALAS unsigned* flag = (ALAS unsigned*)(shm + L_FLAG);
    const int NT = (q0 + 256) / 64;
    const bf16_t* ksrc = K + (rowbase + lane) * PITCH + h * 64 + wid * 8;
    const bf16_t* vsrc = V + (rowbase + 16 * (wid & 3) + (lane >> 2)) * PITCH + h * 64 + (wid >> 2) * 32 + (lane & 3) * 8;
    const unsigned kdst = lds0 + L_K + wid * 1024, vdst = lds0 + L_V + wid * 1024;
#define ATT_DMA(t, so) do { glds16(ksrc + (long)(t) * 64 * PITCH, (unsigned)__builtin_amdgcn_readfirstlane(kdst + (so))); glds16(vsrc + (long)(t) * 64 * PITCH, (unsigned)__builtin_amdgcn_readfirstlane(vdst + (so))); } while (0)
    ATT_DMA(NT - 1, 0);
    bf16x8 qr[4];
    { const bf16_t* Qw = Q + (rowbase + qrow) * PITCH + h * 64 + hi * 8;
#pragma unroll
      for (int d0 = 0; d0 < 4; ++d0) qr[d0] = *(const bf16x8*)(Qw + d0 * 16); }
    float cq2 = 0.f;
    if (!SB) { for (int i = tid; i < q0 + 256; i += 512) ck[i] = cum[i] * LOG2E; cq2 = cum[qrow] * LOG2E; }
    f32x16 o0 = {}, o1 = {};
    float m_run = -INFINITY, l_run = 0.f, carry = 0.f;
    const ALAS unsigned char* kp0 = shm + L_K + hi * 1024 + r32 * 16;
    const ALAS unsigned char* vp0 = shm + L_V + ((lane >> 4) & 1) * 32 + (lane & 3) * 8 + (4 * hi + ((lane & 15) >> 2)) * 64;
    int slot = 0;
    for (int t = NT - 1; t >= 0; --t) {
        if (SB && t < NT - 1) {
            const u32x4 f0 = *(const ALAS u32x4*)flag, f1 = *(const ALAS u32x4*)(flag + 4);
            const unsigned all = f0.x & f0.y & f0.z & f0.w & f1.x & f1.y & f1.z & f1.w;
            if (__builtin_amdgcn_readfirstlane(all) != 0u) break;
        }
        if (t > 0) { ATT_DMA(t - 1, (slot ^ 1) * SLOTB); ATT_WAIT_BAR(2); } else { ATT_WAIT_BAR(0); }
        const int kv0 = 64 * t;
        if (kv0 <= wq0 + 31) {
            const bool needmask = (kv0 + 63 >= wq0);
            const ALAS unsigned char* kp = kp0 + slot * SLOTB;
            f32x16 p0, p1;
            if (!SB) {
                const ALAS float* ckp = ck + kv0 + 4 * hi;
#pragma unroll
                for (int g = 0; g < 4; ++g) { const f32x4 c0 = *(const ALAS f32x4*)(ckp + 8 * g), c1 = *(const ALAS f32x4*)(ckp + 32 + 8 * g);
#pragma unroll
                    for (int e = 0; e < 4; ++e) { p0[4 * g + e] = cq2 - c0[e]; p1[4 * g + e] = cq2 - c1[e]; } }
            } else { p0 = f32x16{}; p1 = f32x16{}; }
#pragma unroll
            for (int d0 = 0; d0 < 4; ++d0) {
                const bf16x8 b0 = *(const ALAS bf16x8*)(kp + d0 * 2048), b1 = *(const ALAS bf16x8*)(kp + d0 * 2048 + 512);
                p0 = __builtin_amdgcn_mfma_f32_32x32x16_bf16(b0, qr[d0], p0, 0, 0, 0);
                p1 = __builtin_amdgcn_mfma_f32_32x32x16_bf16(b1, qr[d0], p1, 0, 0, 0);
            }
            if (!SB) {
                if (needmask) {
#pragma unroll
                    for (int r = 0; r < 16; ++r) { const int kv = kv0 + crow(r, hi); if (kv > qrow) p0[r] = -INFINITY; if (kv + 32 > qrow) p1[r] = -INFINITY; }
                }
                float mx = fmaxf(p0[0], p1[0]);
#pragma unroll
                for (int r = 1; r < 16; ++r) mx = fmaxf(mx, fmaxf(p0[r], p1[r]));
                { auto rr = __builtin_amdgcn_permlane32_swap(__float_as_uint(mx), __float_as_uint(mx), false, false); mx = fmaxf(__uint_as_float(rr[0]), __uint_as_float(rr[1])); }
                const float m_new = fmaxf(m_run, mx);
                const float alpha = __builtin_amdgcn_exp2f(m_run - m_new);
                m_run = m_new;
                float s = 0.f;
#pragma unroll
                for (int r = 0; r < 16; ++r) { p0[r] = __builtin_amdgcn_exp2f(p0[r] - m_new); p1[r] = __builtin_amdgcn_exp2f(p1[r] - m_new); s += p0[r] + p1[r]; }
                l_run = l_run * alpha + s;
#pragma unroll
                for (int r = 0; r < 16; ++r) { o0[r] *= alpha; o1[r] *= alpha; }
            } else {
                f32x16 L0, L1;
#pragma unroll
                for (int r = 0; r < 16; ++r) {
                    const float z0 = p0[r], z1 = p1[r];
                    float l0 = fminf(-z0, 0.f) - __builtin_amdgcn_logf(1.f + __builtin_amdgcn_exp2f(-fabsf(z0)));
                    float l1 = fminf(-z1, 0.f) - __builtin_amdgcn_logf(1.f + __builtin_amdgcn_exp2f(-fabsf(z1)));
                    if (needmask) { const int kv = kv0 + crow(r, hi); if (kv >= qrow) l0 = 0.f; if (kv + 32 >= qrow) l1 = 0.f; }
                    L0[r] = l0; L1[r] = l1;
                }
                float lo[8], hv[8];
#pragma unroll
                for (int g = 0; g < 4; ++g) {
                    const float g0 = (L0[4 * g] + L0[4 * g + 1]) + (L0[4 * g + 2] + L0[4 * g + 3]);
                    const float g1 = (L1[4 * g] + L1[4 * g + 1]) + (L1[4 * g + 2] + L1[4 * g + 3]);
                    auto r0 = __builtin_amdgcn_permlane32_swap(__float_as_uint(g0), __float_as_uint(g0), false, false);
                    auto r1 = __builtin_amdgcn_permlane32_swap(__float_as_uint(g1), __float_as_uint(g1), false, false);
                    lo[g] = __uint_as_float(r0[0]); hv[g] = __uint_as_float(r0[1]); lo[4 + g] = __uint_as_float(r1[0]); hv[4 + g] = __uint_as_float(r1[1]);
                }
                float E[8]; float R = carry;
#pragma unroll
                for (int i = 7; i >= 0; --i) { const float eh = R; R += hv[i]; const float el = R; R += lo[i]; E[i] = hi ? eh : el; }
                carry = R;
#pragma unroll
                for (int g = 0; g < 4; ++g) {
                    float run0 = E[g], run1 = E[4 + g];
#pragma unroll
                    for (int e = 3; e >= 0; --e) { const int r = 4 * g + e;
                        run0 += L0[r]; run1 += L1[r];
                        float w0 = __builtin_amdgcn_exp2f(p0[r] + run0), w1 = __builtin_amdgcn_exp2f(p1[r] + run1);
                        if (needmask) { const int kv = kv0 + crow(r, hi); if (kv >= qrow) w0 = 0.f; if (kv + 32 >= qrow) w1 = 0.f; }
                        p0[r] = w0; p1[r] = w1; }
                }
            }
            u32x4 w;
            bf16x8 pa[4];
            w = (u32x4){cvtpk(p0[0], p0[1]), cvtpk(p0[2], p0[3]), cvtpk(p0[4], p0[5]), cvtpk(p0[6], p0[7])}; pa[0] = __builtin_bit_cast(bf16x8, w);
            w = (u32x4){cvtpk(p0[8], p0[9]), cvtpk(p0[10], p0[11]), cvtpk(p0[12], p0[13]), cvtpk(p0[14], p0[15])}; pa[1] = __builtin_bit_cast(bf16x8, w);
            w = (u32x4){cvtpk(p1[0], p1[1]), cvtpk(p1[2], p1[3]), cvtpk(p1[4], p1[5]), cvtpk(p1[6], p1[7])}; pa[2] = __builtin_bit_cast(bf16x8, w);
            w = (u32x4){cvtpk(p1[8], p1[9]), cvtpk(p1[10], p1[11]), cvtpk(p1[12], p1[13]), cvtpk(p1[14], p1[15])}; pa[3] = __builtin_bit_cast(bf16x8, w);
            const ALAS unsigned char* vp = vp0 + slot * SLOTB;
#pragma unroll
            for (int s = 0; s < 4; ++s) {
                const s16x4 a0 = vtr(vp + s * 1024), a1 = vtr(vp + s * 1024 + 512), c0 = vtr(vp + 4096 + s * 1024), c1 = vtr(vp + 4096 + s * 1024 + 512);
                const bf16x8 v0 = {a0[0], a0[1], a0[2], a0[3], a1[0], a1[1], a1[2], a1[3]}, v1 = {c0[0], c0[1], c0[2], c0[3], c1[0], c1[1], c1[2], c1[3]};
                o0 = __builtin_amdgcn_mfma_f32_32x32x16_bf16(v0, pa[s], o0, 0, 0, 0);
                o1 = __builtin_amdgcn_mfma_f32_32x32x16_bf16(v1, pa[s], o1, 0, 0, 0);
            }
        }
        if (SB) { const int done = __all(carry < SB_DONE); if (lane == 0) flag[wid] = done ? 1u : 0u; }
        ATT_BAR();
        slot ^= 1;
    }
    asm volatile("s_waitcnt vmcnt(0) lgkmcnt(0)\n\ts_barrier" ::: "memory");
    float inv = 1.f;
    if (!SB) { auto rr = __builtin_amdgcn_permlane32_swap(__float_as_uint(l_run), __float_as_uint(l_run), false, false); inv = 1.f / (__uint_as_float(rr[0]) + __uint_as_float(rr[1])); }
    bf16_t* Ow = O + (rowbase + qrow) * 512 + h * 64 + 4 * hi;
#pragma unroll
    for (int g = 0; g < 4; ++g) {
        u32x2 w0, w1;
        w0.x = cvtpk(o0[4 * g] * inv, o0[4 * g + 1] * inv); w0.y = cvtpk(o0[4 * g + 2] * inv, o0[4 * g + 3] * inv);
        w1.x = cvtpk(o1[4 * g] * inv, o1[4 * g + 1] * inv); w1.y = cvtpk(o1[4 * g + 2] * inv, o1[4 * g + 3] * inv);
        *(u32x2*)(Ow + 8 * g) = w0; *(u32x2*)(Ow + 32 + 8 * g) = w1;
    }
#undef ATT_DMA
}
}

#define LAS __attribute__((address_space(3)))
typedef unsigned short bf16;
typedef float f32x4 __attribute__((ext_vector_type(4)));
typedef unsigned u32x4v __attribute__((ext_vector_type(4)));
typedef unsigned u32x2v __attribute__((ext_vector_type(2)));
constexpr int NB = 16, SEQ = 4096, DM = 1024, T = NB * SEQ, DFF = 2816, DINP = 5128, NIN = 5120, NMOD = 6144;
constexpr float RMS_EPS = 1e-6f;
constexpr float QSCALE = 0.125f * 1.4426950408889634f;
constexpr size_t MiB = 1u << 20;
constexpr size_t WS_MOD = 1 * MiB, WS_LOGF = 2 * MiB, WS_CUM = 4 * MiB, WS_WIN = 8 * MiB, WS_WSB = 18 * MiB, WS_WFX = 19 * MiB, WS_WOUT = 20 * MiB, WS_WGU = 22 * MiB, WS_WDN = 34 * MiB;
constexpr size_t WS_H = 64 * MiB, WS_YSB = 192 * MiB, WS_YFX = 256 * MiB, WS_GATES = 320 * MiB, WS_QKV = 576 * MiB, WS_ACT = 576 * MiB, WS_END = 960 * MiB;
constexpr int LDS_BYTES = 147456;
constexpr int NPHASE = 11;

struct Args { const float* in[16]; float* out; unsigned char* ws; int ph_lo, ph_hi; };

__device__ __forceinline__ float wave_sum(float v) {
#pragma unroll
    for (int o = 1; o < 64; o <<= 1) v += __shfl_xor(v, o);
    return v;
}
__device__ __forceinline__ unsigned f2bf(float f) { unsigned u = __builtin_bit_cast(unsigned, f); return (u + 0x7fffu + ((u >> 16) & 1u)) >> 16; }
__device__ __forceinline__ unsigned pk2(float lo, float hi) { return f2bf(lo) | (f2bf(hi) << 16); }

__device__ __forceinline__ void transpose_item(const float* W, int ldw, int K, int src_col0, bf16* WT, int dst_row0, int k0, LAS float* scr, int lane) {
#pragma unroll 8
    for (int i = 0; i < 32; ++i) { const int kk = 2 * i + (lane >> 5); scr[kk * 33 + (lane & 31)] = W[(size_t)(k0 + kk) * ldw + src_col0 + (lane & 31)]; }
    asm volatile("s_waitcnt lgkmcnt(0)" ::: "memory");
    const int c = lane & 7;
#pragma unroll
    for (int j = 0; j < 4; ++j) { const int n = (lane >> 3) + 8 * j; const LAS float* s = scr + (8 * c) * 33 + n;
        u32x4v o; o.x = pk2(s[0 * 33], s[1 * 33]); o.y = pk2(s[2 * 33], s[3 * 33]); o.z = pk2(s[4 * 33], s[5 * 33]); o.w = pk2(s[6 * 33], s[7 * 33]);
        *(u32x4v*)(WT + (size_t)(dst_row0 + n) * K + k0 + 8 * c) = o; }
    asm volatile("s_waitcnt lgkmcnt(0)" ::: "memory");
}

__device__ __forceinline__ void phase_prologue(const Args& a, LAS unsigned char* lds, int tid, int lane, int wave, int G) {
    unsigned char* ws = a.ws;
    float* mod = (float*)(ws + WS_MOD);
    for (int item = blockIdx.x; item < NMOD / 64; item += G) {
        LAS float* sc = (LAS float*)lds;
        LAS float* red = (LAS float*)(lds + 65536);
        const float* c = a.in[1];
        for (int i = tid; i < NB * DM; i += 512) { const int b = i >> 10, k = i & 1023; const float v = c[i]; sc[k * 16 + b] = v / (1.f + __expf(-v)); }
        __syncthreads();
        const float* w = a.in[2] + item * 64 + lane;
        float acc[16];
#pragma unroll
        for (int b = 0; b < 16; ++b) acc[b] = 0.f;
        const int k0 = wave * 128;
#pragma unroll 4
        for (int k = k0; k < k0 + 128; ++k) {
            const float wv = w[(size_t)k * NMOD];
            const LAS f32x4* s4 = (const LAS f32x4*)(sc + k * 16);
#pragma unroll
            for (int q = 0; q < 4; ++q) { const f32x4 s = s4[q]; acc[4 * q] += s.x * wv; acc[4 * q + 1] += s.y * wv; acc[4 * q + 2] += s.z * wv; acc[4 * q + 3] += s.w * wv; }
        }
#pragma unroll
        for (int b = 0; b < 16; ++b) red[(wave * 16 + b) * 64 + lane] = acc[b];
        __syncthreads();
        for (int o = tid; o < 1024; o += 512) { const int b = o >> 6, l = o & 63; float s = 0.f;
#pragma unroll
            for (int w8 = 0; w8 < 8; ++w8) s += red[(w8 * 16 + b) * 64 + l];
            mod[b * NMOD + item * 64 + l] = s + a.in[3][item * 64 + l]; }
        __syncthreads();
    }
    LAS float* scr = (LAS float*)(lds + wave * 16384);
    const int gw = blockIdx.x * 8 + wave, NGW = G * 8;
    bf16* WIN = (bf16*)(ws + WS_WIN); bf16* WSB = (bf16*)(ws + WS_WSB); bf16* WFX = (bf16*)(ws + WS_WFX); bf16* WOUT = (bf16*)(ws + WS_WOUT); bf16* WGU = (bf16*)(ws + WS_WGU); bf16* WDN = (bf16*)(ws + WS_WDN);
    constexpr int I0 = 16 * 96, I1 = 16 * 64, I2 = 8 * 32, I3 = 8 * 32, I4 = 16 * 32, I5 = 16 * 88, I6 = 16 * 88, I7 = 44 * 32;
    constexpr int NITEMS = I0 + I1 + I2 + I3 + I4 + I5 + I6 + I7;
    for (int it = gw; it < NITEMS; it += NGW) {
        int r = it;
        if (r < I0) { const int kb = r / 96, nb = r % 96; transpose_item(a.in[5], DINP, 1024, 32 * nb, WIN, 32 * nb, 64 * kb, scr, lane); continue; } r -= I0;
        if (r < I1) { const int kb = r / 64, nb = r % 64; transpose_item(a.in[5], DINP, 1024, 3080 + 32 * nb, WIN, 3072 + 32 * nb, 64 * kb, scr, lane); continue; } r -= I1;
        if (r < I2) { const int kb = r / 32, nb = r % 32; transpose_item(a.in[8], 1024, 512, 32 * nb, WSB, 32 * nb, 64 * kb, scr, lane); continue; } r -= I2;
        if (r < I3) { const int kb = r / 32, nb = r % 32; transpose_item(a.in[9], 1024, 512, 32 * nb, WFX, 32 * nb, 64 * kb, scr, lane); continue; } r -= I3;
        if (r < I4) { const int kb = r / 32, nb = r % 32; transpose_item(a.in[10], 1024, 1024, 32 * nb, WOUT, 32 * nb, 64 * kb, scr, lane); continue; } r -= I4;
        if (r < I5) { const int kb = r / 88, nb = r % 88, n0 = 32 * nb; transpose_item(a.in[12], DFF, 1024, n0, WGU, (n0 >> 7) * 256 + (n0 & 127), 64 * kb, scr, lane); continue; } r -= I5;
        if (r < I6) { const int kb = r / 88, nb = r % 88, n0 = 32 * nb; transpose_item(a.in[13], DFF, 1024, n0, WGU, (n0 >> 7) * 256 + 128 + (n0 & 127), 64 * kb, scr, lane); continue; } r -= I6;
        { const int kb = r / 32, nb = r % 32; transpose_item(a.in[14], 1024, DFF, 32 * nb, WDN, 32 * nb, 64 * kb, scr, lane); }
    }
}

template <int MODE>
__device__ __forceinline__ void norm_pass(const Args& a, LAS unsigned char* lds, int tid, int lane, int wave, int G) {
    unsigned char* ws = a.ws;
    const float* mod = (const float*)(ws + WS_MOD);
    const float* src = MODE == 0 ? a.in[0] : a.out;
    const float* gvec = MODE == 0 ? a.in[4] : (MODE == 1 ? a.in[11] : a.in[15]);
    constexpr int SH = MODE == 0 ? 0 : 3 * DM, SC = MODE == 0 ? DM : 4 * DM;
    bf16* H = (bf16*)(ws + WS_H);
    float* LOGF = (float*)(ws + WS_LOGF);
    LAS float* wfL = (LAS float*)lds;
    if (MODE == 0) {
        for (int i = tid; i < 8192; i += 512) { const int jj = i >> 10, k = i & 1023; wfL[i] = a.in[5][(size_t)k * DINP + 3072 + jj]; }
        __syncthreads();
    }
    const int gw = blockIdx.x * 8 + wave, NGW = G * 8;
    for (int r0 = gw * 32; r0 < T; r0 += NGW * 32) {
        const int b = r0 >> 12;
        f32x4 gs[4], sh[4];
#pragma unroll
        for (int j = 0; j < 4; ++j) { const int col = 4 * lane + 256 * j; const f32x4 g4 = *(const f32x4*)(gvec + col);
            if (MODE < 2) { const f32x4 s4 = *(const f32x4*)(mod + b * NMOD + SC + col); sh[j] = *(const f32x4*)(mod + b * NMOD + SH + col); gs[j] = g4 * (1.f + s4); }
            else { gs[j] = g4; sh[j] = (f32x4){0.f, 0.f, 0.f, 0.f}; } }
        f32x4 vn[4];
        { const f32x4* xr = (const f32x4*)(src + (size_t)r0 * DM) + lane;
#pragma unroll
          for (int j = 0; j < 4; ++j) vn[j] = xr[64 * j]; }
        for (int rr = 0; rr < 32; ++rr) {
            const size_t row = (size_t)r0 + rr;
            f32x4 v[4];
#pragma unroll
            for (int j = 0; j < 4; ++j) v[j] = vn[j];
            if (rr < 31) { const f32x4* xr = (const f32x4*)(src + (row + 1) * DM) + lane;
#pragma unroll
                for (int j = 0; j < 4; ++j) vn[j] = xr[64 * j]; }
            float ss = 0.f;
#pragma unroll
            for (int j = 0; j < 4; ++j) ss += (v[j].x * v[j].x + v[j].y * v[j].y) + (v[j].z * v[j].z + v[j].w * v[j].w);
            ss = wave_sum(ss);
            const float rstd = 1.0f / sqrtf(ss * (1.0f / DM) + RMS_EPS);
#pragma unroll
            for (int j = 0; j < 4; ++j) v[j] = v[j] * rstd * gs[j] + sh[j];
            if (MODE == 2) { f32x4* o = (f32x4*)(a.out + row * DM) + lane;
#pragma unroll
                for (int j = 0; j < 4; ++j) o[64 * j] = v[j]; }
            else { u32x2v* o = (u32x2v*)(H + row * DM) + lane;
#pragma unroll
                for (int j = 0; j < 4; ++j) { u32x2v w; w.x = pk2(v[j].x, v[j].y); w.y = pk2(v[j].z, v[j].w); o[64 * j] = w; } }
            if (MODE == 0) {
                float f[8];
#pragma unroll
                for (int jj = 0; jj < 8; ++jj) { float s = 0.f;
#pragma unroll
                    for (int j = 0; j < 4; ++j) { const f32x4 w4 = *(const LAS f32x4*)(wfL + jj * 1024 + 4 * lane + 256 * j); s += (v[j].x * w4.x + v[j].y * w4.y) + (v[j].z * w4.z + v[j].w * w4.w); }
                    f[jj] = s; }
                const bool h5 = (lane & 32) != 0, h4 = (lane & 16) != 0, h3 = (lane & 8) != 0;
#pragma unroll
                for (int i = 0; i < 4; ++i) { const float send = h5 ? f[i] : f[i + 4], keep = h5 ? f[i + 4] : f[i]; f[i] = keep + __shfl_xor(send, 32); }
#pragma unroll
                for (int i = 0; i < 2; ++i) { const float send = h4 ? f[i] : f[i + 2], keep = h4 ? f[i + 2] : f[i]; f[i] = keep + __shfl_xor(send, 16); }
                { const float send = h3 ? f[0] : f[1], keep = h3 ? f[1] : f[0]; f[0] = keep + __shfl_xor(send, 8); }
                f[0] += __shfl_xor(f[0], 4); f[0] += __shfl_xor(f[0], 2); f[0] += __shfl_xor(f[0], 1);
                if ((lane & 7) == 0) { const int jj = lane >> 3; const float val = f[0] + a.in[6][jj];
                    LOGF[((size_t)(b * 8 + jj) << 12) + (row & 4095)] = fminf(val, 0.f) - log1pf(__expf(-fabsf(val))); }
            }
        }
    }
}

__device__ __forceinline__ void scan_phase(const Args& a, LAS unsigned char* lds, int tid, int lane, int wave, int G) {
    const float* LOGF = (const float*)(a.ws + WS_LOGF); float* CUM = (float*)(a.ws + WS_CUM);
    LAS float* wt = (LAS float*)lds;
    for (int bh = blockIdx.x; bh < 128; bh += G) {
        const f32x4* src = (const f32x4*)(LOGF + (size_t)bh * SEQ + tid * 8);
        f32x4 a0 = src[0], a1 = src[1];
        a0.y += a0.x; a0.z += a0.y; a0.w += a0.z; a1.x += a0.w; a1.y += a1.x; a1.z += a1.y; a1.w += a1.z;
        const float tot = a1.w; float sc = tot;
#pragma unroll
        for (int o = 1; o < 64; o <<= 1) { const float n = __shfl_up(sc, o); if (lane >= o) sc += n; }
        if (lane == 63) wt[wave] = sc;
        __syncthreads();
        float off = sc - tot;
        for (int w8 = 0; w8 < wave; ++w8) off += wt[w8];
        a0 += off; a1 += off;
        f32x4* dst = (f32x4*)(CUM + (size_t)bh * SEQ + tid * 8);
        dst[0] = a0; dst[1] = a1;
        __syncthreads();
    }
}

__device__ __forceinline__ void dbg_dump(const Args& a, const bf16* src, int pitch, int col0, int tid, int G) {
    for (size_t i = (size_t)blockIdx.x * 512 + tid; i < (size_t)T * DM; i += (size_t)G * 512) { const size_t t = i >> 10; const int c = (int)(i & 1023);
        a.out[i] = __uint_as_float((unsigned)src[t * pitch + col0 + c] << 16); }
}
__global__ void __launch_bounds__(512, 2) mega_fwd(Args a) {
    extern __shared__ __attribute__((aligned(16))) unsigned char lds_raw[];
    LAS unsigned char* lds = (LAS unsigned char*)lds_raw;
    cg::grid_group grid = cg::this_grid();
    const int tid = threadIdx.x, lane = tid & 63, wave = __builtin_amdgcn_readfirstlane(tid >> 6);
    const int G = gridDim.x, bx = blockIdx.x;
    unsigned char* ws = a.ws;
    const int lo = a.ph_lo, hi = a.ph_hi;
#define IN(k) (lo <= (k) && (k) < hi)
#define SEAM(k) do { if (IN(k) && IN((k) + 1)) { asm volatile("s_waitcnt vmcnt(0) lgkmcnt(0)" ::: "memory"); __syncthreads(); grid.sync(); asm volatile("s_waitcnt vmcnt(0)" ::: "memory"); __syncthreads(); } } while (0)
    bf16* H = (bf16*)(ws + WS_H); bf16* QKV = (bf16*)(ws + WS_QKV); bf16* GATES = (bf16*)(ws + WS_GATES); bf16* YSB = (bf16*)(ws + WS_YSB); bf16* YFX = (bf16*)(ws + WS_YFX); bf16* ACT = (bf16*)(ws + WS_ACT);
    const float* mod = (const float*)(ws + WS_MOD);

    if (IN(0)) phase_prologue(a, lds, tid, lane, wave, G);
    SEAM(0);
    if (IN(1)) norm_pass<0>(a, lds, tid, lane, wave, G);
    SEAM(1);
#if defined(DBG_DUMP) && DBG_DUMP == 1
    dbg_dump(a, H, 1024, 0, tid, G); return;
#endif
    if (IN(2)) {
        scan_phase(a, lds, tid, lane, wave, G);
        pg8::Gemm g{H, (const bf16*)(ws + WS_WIN), T, NIN, DM}; pg8::StaticOrder S; S.init(T, NIN, G, bx);
        pg8::EpiIn E{QKV, GATES, a.in[7], QSCALE};
        pg8::gemm_phase<pg8::EpiIn, pg8::StaticOrder, true, true>(lds, g, S, E);
    }
    SEAM(2);
#if defined(DBG_DUMP) && DBG_DUMP == 2
    dbg_dump(a, QKV, 3072, 0, tid, G); return;
#endif
#if defined(DBG_DUMP) && DBG_DUMP == 3
    dbg_dump(a, QKV, 3072, 2048, tid, G); return;
#endif
#if defined(DBG_DUMP) && DBG_DUMP == 4
    dbg_dump(a, GATES, 2048, 0, tid, G); return;
#endif
    if (IN(3)) {
        const int vcu = (G % 8 == 0) ? (bx % 8) * (G / 8) + bx / 8 : bx;
        const float* CUM = (const float*)(ws + WS_CUM);
        for (int vc = vcu; vc < 256; vc += G) {
            const int bh = vc >> 1, half = vc & 1, b = bh >> 3, h = bh & 7;
#ifdef DBG_COPYV
            { for (int i = tid; i < 4096 * 64 / 8; i += 512) { const int row = i >> 3, ch = i & 7;
                *(u32x4v*)(YSB + ((size_t)b * SEQ + row) * 512 + h * 64 + ch * 8) = *(const u32x4v*)(QKV + ((size_t)b * SEQ + row) * 3072 + 1024 + h * 64 + ch * 8);
                *(u32x4v*)(YFX + ((size_t)b * SEQ + row) * 512 + h * 64 + ch * 8) = *(const u32x4v*)(QKV + ((size_t)b * SEQ + row) * 3072 + 2560 + h * 64 + ch * 8); } continue; }
#endif
#ifdef DBG_NOATT
            { for (int i = tid; i < 4096 * 64 / 8; i += 512) { const int row = i >> 3, ch = i & 7; u32x4v z = {0u, 0u, 0u, 0u};
                *(u32x4v*)(YSB + ((size_t)b * SEQ + row) * 512 + h * 64 + ch * 8) = z; *(u32x4v*)(YFX + ((size_t)b * SEQ + row) * 512 + h * 64 + ch * 8) = z; } continue; }
#endif
            for (int i = 0; i < 8; ++i) { const int s = 2 * (i >> 1) + half, qb = (i & 1) ? 15 - s : s;
                att::attn_unit<false>(b, h, qb, QKV + 1536, QKV + 2048, QKV + 2560, CUM + (size_t)bh * SEQ, YFX, lds); }
            for (int i = 0; i < 8; ++i) { const int s = 2 * (i >> 1) + half, qb = (i & 1) ? 15 - s : s;
                att::attn_unit<true>(b, h, qb, QKV, QKV + 512, QKV + 1024, nullptr, YSB, lds); }
#ifdef DBG_ZERO_SB
            __syncthreads();
            { for (int i = tid; i < 4096 * 64 / 8; i += 512) { const int row = i >> 3, ch = i & 7; u32x4v z = {0u, 0u, 0u, 0u};
                *(u32x4v*)(YSB + ((size_t)b * SEQ + row) * 512 + h * 64 + ch * 8) = z; } }
#endif
#ifdef DBG_ZERO_FX
            __syncthreads();
            { for (int i = tid; i < 4096 * 64 / 8; i += 512) { const int row = i >> 3, ch = i & 7; u32x4v z = {0u, 0u, 0u, 0u};
                *(u32x4v*)(YFX + ((size_t)b * SEQ + row) * 512 + h * 64 + ch * 8) = z; } }
#endif
        }
    }
    SEAM(3);
    if (IN(4)) {
        pg8::Gemm g{YSB, (const bf16*)(ws + WS_WSB), T, DM, 512}; pg8::StaticOrder S; S.init(T, DM, G, bx);
        pg8::EpiBranch<true> E{H, GATES, 0};
        pg8::gemm_phase<pg8::EpiBranch<true>, pg8::StaticOrder, true, true>(lds, g, S, E);
    }
#ifdef DBG_NOP5
    if (false) {
#else
    if (IN(5)) {
#endif
        pg8::Gemm g{YFX, (const bf16*)(ws + WS_WFX), T, DM, 512}; pg8::StaticOrder S; S.init(T, DM, G, bx);
        pg8::EpiBranch<false> E{H, GATES, 1024};
        pg8::gemm_phase<pg8::EpiBranch<false>, pg8::StaticOrder, true, true>(lds, g, S, E);
    }
    SEAM(5);
#if defined(DBG_DUMP) && DBG_DUMP == 5
    dbg_dump(a, H, 1024, 0, tid, G); return;
#endif
    if (IN(6)) {
        pg8::Gemm g{H, (const bf16*)(ws + WS_WOUT), T, DM, DM}; pg8::StaticOrder S; S.init(T, DM, G, bx);
        pg8::EpiResid E{a.in[0], a.out, mod + 2 * DM};
        pg8::gemm_phase<pg8::EpiResid, pg8::StaticOrder, true, true>(lds, g, S, E);
    }
    SEAM(6);
    if (IN(7)) norm_pass<1>(a, lds, tid, lane, wave, G);
    SEAM(7);
    if (IN(8)) {
        pg8::Gemm g{H, (const bf16*)(ws + WS_WGU), T, 2 * DFF, DM}; pg8::StaticOrder S; S.init(T, 2 * DFF, G, bx);
        pg8::EpiSwiglu E{ACT};
        pg8::gemm_phase<pg8::EpiSwiglu, pg8::StaticOrder, true, true>(lds, g, S, E);
    }
    SEAM(8);
    if (IN(9)) {
        pg8::Gemm g{ACT, (const bf16*)(ws + WS_WDN), T, DM, DFF}; pg8::StaticOrder S; S.init(T, DM, G, bx);
        pg8::EpiResid E{a.out, a.out, mod + 5 * DM};
        pg8::gemm_phase<pg8::EpiResid, pg8::StaticOrder, true, true>(lds, g, S, E);
    }
    SEAM(9);
    if (IN(10)) norm_pass<2>(a, lds, tid, lane, wave, G);
#undef IN
#undef SEAM
}

extern "C" void kernel_launch(void* const* d_in, const int* in_sizes, int n_in, void* d_out, int out_size, void* d_ws, size_t ws_size, hipStream_t stream) {
    static int grid = 0;
    if (grid == 0) {
        if (n_in != 16 || in_sizes[0] != T * DM || out_size != T * DM || ws_size < WS_END) { fprintf(stderr, "kernel_launch: unexpected shapes (n_in %d, in0 %d, out %d, ws %zu)\n", n_in, n_in > 0 ? in_sizes[0] : -1, out_size, ws_size); grid = -1; return; }
        int dev = 0, cus = 0, per_cu = 0;
        if (hipGetDevice(&dev) != hipSuccess || hipDeviceGetAttribute(&cus, hipDeviceAttributeMultiprocessorCount, dev) != hipSuccess) { grid = -1; return; }
        if (hipFuncSetAttribute((const void*)mega_fwd, hipFuncAttributeMaxDynamicSharedMemorySize, LDS_BYTES) != hipSuccess) { fprintf(stderr, "kernel_launch: hipFuncSetAttribute failed\n"); grid = -1; return; }
        if (hipOccupancyMaxActiveBlocksPerMultiprocessor(&per_cu, (const void*)mega_fwd, 512, LDS_BYTES) != hipSuccess || per_cu < 1) { fprintf(stderr, "kernel_launch: occupancy query says %d\n", per_cu); per_cu = 1; }
        (void)hipGetLastError();
        grid = cus * per_cu;
    }
    if (grid < 0) return;
    Args a{};
    for (int i = 0; i < 16; ++i) a.in[i] = (const float*)d_in[i];
    a.out = (float*)d_out; a.ws = (unsigned char*)d_ws;
#ifndef MK_SPLIT
#define MK_SPLIT 0
#endif
    for (int p0 = 0; p0 < NPHASE; p0 += (MK_SPLIT ? 1 : NPHASE)) {
        a.ph_lo = p0; a.ph_hi = MK_SPLIT ? p0 + 1 : NPHASE;
        void* args[] = {&a};
        const hipError_t e = hipLaunchCooperativeKernel((const void*)mega_fwd, dim3(grid), dim3(512), args, LDS_BYTES, stream);
        if (e != hipSuccess) fprintf(stderr, "kernel_launch: cooperative launch failed: %s (grid %d)\n", hipGetErrorString(e), grid);
    }
}
```

```cpp
#include <hip/hip_runtime.h>
#include <hip/hip_cooperative_groups.h>
#include <cstdio>
#include <cstdint>
namespace cg = cooperative_groups;
namespace pg8 {
#define PG8_LAS __attribute__((address_space(3)))
typedef unsigned short bf16_t;
typedef short bf16x8 __attribute__((ext_vector_type(8)));
typedef float f32x4 __attribute__((ext_vector_type(4)));
typedef unsigned u32x4 __attribute__((ext_vector_type(4)));
constexpr int BM = 256, BK = 64, HALF = 128, HTB = HALF * BK * 2  , STAGE_BYTES = 8 * HTB, NXCD = 8, WGM = 8;

__host__ __device__ __forceinline__ int lds_byte(int r, int c) { const int st = (r >> 4) * 2 + (c >> 5), rr = r & 15, cc = c & 31, ob = rr * 64 + cc * 2; return st * 1024 + (ob ^ (((ob >> 9) & 1) << 5)); }
__host__ __device__ __forceinline__ void stage_rc(int b, int& R, int& C) { const int st = b / 1024, sb = b % 1024, swz = sb ^ (((sb >> 9) & 1) << 5); R = (st >> 1) * 16 + swz / 64; C = (st & 1) * 32 + (swz % 64) / 2; }
__host__ __device__ __forceinline__ int perm32(int rho) { const int n = rho >> 4, i = rho & 15; return 8 * (i >> 2) + 4 * n + (i & 3); }

struct Unit { int pm, pn; };
struct Gemm { const bf16_t* A; const bf16_t* Bt; int M, N, K; };

struct StaticOrder {
    int nM, nN, nwg, G, c;
    __host__ __device__ void init(int M, int N, int G_, int c_) { nM = M / BM; nN = N / BM; nwg = nM * nN; G = G_; c = c_; }
    __host__ __device__ bool next(int i, Unit& u) const {
        const long L = (long)i * G + c; if (L >= nwg) return false;
        int wgid = (int)L; { const int q = nwg / NXCD, r = nwg % NXCD, xcd = wgid % NXCD, off = wgid / NXCD; wgid = (xcd < r ? xcd * (q + 1) : r * (q + 1) + (xcd - r) * q) + off; }
        const int nig = WGM * nN, gid = wgid / nig, fm = gid * WGM, gsz = (nM - fm) < WGM ? (nM - fm) : WGM;
        u.pm = fm + ((wgid % nig) % gsz); u.pn = (wgid % nig) / gsz; return true;
    }
    __device__ __forceinline__ void a_ready(const Unit&) const {}
    __device__ __forceinline__ void done(const Unit&) const {}
};

typedef float f32x2_cv __attribute__((ext_vector_type(2))); typedef __bf16 bf16x2_cv __attribute__((ext_vector_type(2)));
__device__ __forceinline__ unsigned cvt_pk_bf16(float lo, float hi) { f32x2_cv v = {lo, hi}; bf16x2_cv b = __builtin_convertvector(v, bf16x2_cv); return __builtin_bit_cast(unsigned, b); }
typedef unsigned u32x2 __attribute__((ext_vector_type(2)));
__device__ __forceinline__ float bf_lo(unsigned w) { return __uint_as_float(w << 16); }
__device__ __forceinline__ float bf_hi(unsigned w) { return __uint_as_float(w & 0xffff0000u); }
__device__ __forceinline__ float fast_sigmoid(float x) { return __builtin_amdgcn_rcpf(1.f + __builtin_amdgcn_exp2f(-1.4426950409f * x)); }
__device__ __forceinline__ u32x4 pack8(f32x4 v0, f32x4 v1) { u32x4 w; w.x = cvt_pk_bf16(v0[0], v0[1]); w.y = cvt_pk_bf16(v0[2], v0[3]); w.z = cvt_pk_bf16(v1[0], v1[1]); w.w = cvt_pk_bf16(v1[2], v1[3]); return w; }

struct EpiIn {
    static constexpr bool PERM = true, AFTER_DRAIN = false;
    bf16_t* qkv; bf16_t* gates; const float* b_gate; float qscale;
    __device__ __forceinline__ void operator()(const f32x4 (&acc)[2][2][4][2], const Unit& u, int wr, int wc, int fr, int fq) const {
        const int row0 = u.pm * BM + wr * 64 + fr;
        if (u.pn < 12) {
            const float sc = (u.pn < 2 || (u.pn >= 6 && u.pn < 8)) ? qscale : 1.f;
            const int col0 = u.pn * BM + wc * 32 + 8 * fq;
#pragma unroll
            for (int ai = 0; ai < 2; ++ai)
#pragma unroll
                for (int m = 0; m < 4; ++m) { bf16_t* rowp = qkv + (size_t)(row0 + ai * HALF + m * 16) * 3072 + col0;
#pragma unroll
                    for (int bj = 0; bj < 2; ++bj) *(u32x4*)(rowp + bj * HALF) = pack8(acc[ai][bj][m][0] * sc, acc[ai][bj][m][1] * sc); }
        } else {
            const int col0 = (u.pn - 12) * BM + wc * 32 + 8 * fq;
            f32x4 bv[2][2];
#pragma unroll
            for (int bj = 0; bj < 2; ++bj)
#pragma unroll
                for (int n = 0; n < 2; ++n) bv[bj][n] = *(const f32x4*)(b_gate + col0 + bj * HALF + 4 * n);
#pragma unroll
            for (int ai = 0; ai < 2; ++ai)
#pragma unroll
                for (int m = 0; m < 4; ++m) { bf16_t* rowp = gates + (size_t)(row0 + ai * HALF + m * 16) * 2048 + col0;
#pragma unroll
                    for (int bj = 0; bj < 2; ++bj) { f32x4 v0 = acc[ai][bj][m][0] + bv[bj][0], v1 = acc[ai][bj][m][1] + bv[bj][1];
#ifndef DBG_NOSIG
#pragma unroll
                        for (int e = 0; e < 4; ++e) { v0[e] = fast_sigmoid(v0[e]); v1[e] = fast_sigmoid(v1[e]); }
#endif
                        *(u32x4*)(rowp + bj * HALF) = pack8(v0, v1); } }
        }
    }
};
template <bool FIRST> struct EpiBranch {
    static constexpr bool PERM = true, AFTER_DRAIN = false;
    bf16_t* merged; const bf16_t* gates; int goff;
    __device__ __forceinline__ void operator()(const f32x4 (&acc)[2][2][4][2], const Unit& u, int wr, int wc, int fr, int fq) const {
        const int row0 = u.pm * BM + wr * 64 + fr, col0 = u.pn * BM + wc * 32 + 8 * fq;
#pragma unroll
        for (int ai = 0; ai < 2; ++ai)
#pragma unroll
            for (int m = 0; m < 4; ++m) { const size_t row = (size_t)(row0 + ai * HALF + m * 16);
#pragma unroll
                for (int bj = 0; bj < 2; ++bj) { const int c = col0 + bj * HALF;
                    const u32x4 gw = *(const u32x4*)(gates + row * 2048 + goff + c);
                    f32x4 g0 = {bf_lo(gw.x), bf_hi(gw.x), bf_lo(gw.y), bf_hi(gw.y)}, g1 = {bf_lo(gw.z), bf_hi(gw.z), bf_lo(gw.w), bf_hi(gw.w)};
                    f32x4 v0 = g0 * acc[ai][bj][m][0], v1 = g1 * acc[ai][bj][m][1];
                    if (!FIRST) { const u32x4 pw = *(const u32x4*)(merged + row * 1024 + c);
                        v0 += (f32x4){bf_lo(pw.x), bf_hi(pw.x), bf_lo(pw.y), bf_hi(pw.y)}; v1 += (f32x4){bf_lo(pw.z), bf_hi(pw.z), bf_lo(pw.w), bf_hi(pw.w)}; }
                    *(u32x4*)(merged + row * 1024 + c) = pack8(v0, v1); } }
    }
};
struct EpiResid {
    static constexpr bool PERM = false, AFTER_DRAIN = false;
    const float* base; float* out; const float* gate;
    __device__ __forceinline__ void operator()(const f32x4 (&acc)[2][2][4][2], const Unit& u, int wr, int wc, int fr, int fq) const {
        const int row0 = u.pm * BM + wr * 64 + fr, col0 = u.pn * BM + wc * 32 + 4 * fq, b = (u.pm * BM) >> 12;
        f32x4 gv[2][2];
#pragma unroll
        for (int bj = 0; bj < 2; ++bj)
#pragma unroll
            for (int n = 0; n < 2; ++n) gv[bj][n] = *(const f32x4*)(gate + (size_t)b * 6144 + col0 + bj * HALF + n * 16);
#pragma unroll
        for (int ai = 0; ai < 2; ++ai)
#pragma unroll
            for (int m = 0; m < 4; ++m) { const size_t off = (size_t)(row0 + ai * HALF + m * 16) * 1024 + col0;
#pragma unroll
                for (int bj = 0; bj < 2; ++bj)
#pragma unroll
                    for (int n = 0; n < 2; ++n) { const f32x4 bs = *(const f32x4*)(base + off + bj * HALF + n * 16);
                        *(f32x4*)(out + off + bj * HALF + n * 16) = bs + gv[bj][n] * acc[ai][bj][m][n]; } }
    }
};
struct EpiSwiglu {
    static constexpr bool PERM = true, AFTER_DRAIN = false;
    bf16_t* A;
    __device__ __forceinline__ void operator()(const f32x4 (&acc)[2][2][4][2], const Unit& u, int wr, int wc, int fr, int fq) const {
        const int row0 = u.pm * BM + wr * 64 + fr, col0 = u.pn * HALF + wc * 32 + 8 * fq;
#pragma unroll
        for (int ai = 0; ai < 2; ++ai)
#pragma unroll
            for (int m = 0; m < 4; ++m) { bf16_t* rowp = A + (size_t)(row0 + ai * HALF + m * 16) * 2816 + col0;
                f32x4 r0, r1;
#pragma unroll
                for (int e = 0; e < 4; ++e) { const float g0 = acc[ai][0][m][0][e], g1 = acc[ai][0][m][1][e];
                    r0[e] = g0 * fast_sigmoid(g0) * acc[ai][1][m][0][e]; r1[e] = g1 * fast_sigmoid(g1) * acc[ai][1][m][1][e]; }
                *(u32x4*)rowp = pack8(r0, r1); }
    }
};

template <class Epi, class Sched, bool ALIGN_EPI = false, bool SP2 = false>
__device__ __forceinline__ void gemm_phase(PG8_LAS unsigned char* lds, const Gemm g, const Sched& S, const Epi& E) {
    const int tid = threadIdx.x, wid = __builtin_amdgcn_readfirstlane(tid >> 6), lane = tid & 63, wr = wid >> 2, wc = wid & 3, fr = lane & 15, fq = lane >> 4;
    const int K = g.K, nt = K / BK;
    unsigned voffA[2], voffB[2];
#pragma unroll
    for (int i = 0; i < 2; ++i) { int R, C; stage_rc(tid * 16 + i * 8192, R, C); const int Rb = Epi::PERM ? ((R & ~31) + perm32(R & 31)) : R;
        voffA[i] = (unsigned)(R * K + C) * 2u; voffB[i] = (unsigned)(Rb * K + C) * 2u; }
    const size_t kstep = (size_t)(BK * 2);
    const size_t hstep = (size_t)HALF * K * 2;
    const size_t tstep = 2 * hstep;
    const unsigned ldsw = (unsigned)wid * 1024u;
    const int aoff = lds_byte(wr * 64 + fr, fq * 8), boff = lds_byte(wc * 32 + fr, fq * 8);
#define PG8_SA(b, h) (((b) * 2 + (h)) * HTB)
#define PG8_SB(b, h) ((4 + (b) * 2 + (h)) * HTB)
#define PG8_STAGE(bufoff, gbase, voff) do { _Pragma("unroll") for (int _i = 0; _i < 2; ++_i) \
        __builtin_amdgcn_global_load_lds((const unsigned*)((const char*)(gbase) + (voff)[_i]), (PG8_LAS unsigned*)(lds + (bufoff) + ldsw + _i * 8192), 16, 0, 0); } while (0)
#define PG8_LDA(dst, b, h) do { _Pragma("unroll") for (int m = 0; m < 4; ++m) _Pragma("unroll") for (int k = 0; k < 2; ++k) dst[m][k] = *(const PG8_LAS bf16x8*)(lds + PG8_SA(b, h) + aoff + m * 2048 + k * 1024); } while (0)
#define PG8_LDB(dst, b, h) do { _Pragma("unroll") for (int n = 0; n < 2; ++n) _Pragma("unroll") for (int k = 0; k < 2; ++k) dst[n][k] = *(const PG8_LAS bf16x8*)(lds + PG8_SB(b, h) + boff + n * 2048 + k * 1024); } while (0)
#define PG8_MMA(ai, bj, At, Bt) do { __builtin_amdgcn_s_setprio(1); _Pragma("unroll") for (int m = 0; m < 4; ++m) _Pragma("unroll") for (int n = 0; n < 2; ++n) _Pragma("unroll") for (int k = 0; k < 2; ++k) \
        acc[ai][bj][m][n] = __builtin_amdgcn_mfma_f32_16x16x32_bf16(Bt[n][k], At[m][k], acc[ai][bj][m][n], 0, 0, 0); __builtin_amdgcn_s_setprio(0); } while (0)
#define PG8_WAIT_V(n) asm volatile("s_waitcnt vmcnt(" #n ")" ::: "memory")
#define PG8_WAIT_L(n) asm volatile("s_waitcnt lgkmcnt(" #n ")" ::: "memory")
#define PG8_BAR __builtin_amdgcn_s_barrier()
#define PG8_SCHED __builtin_amdgcn_sched_barrier(0)
    Unit cur, nxt; int ui = 0;
    if (!S.next(0, cur)) return;
    f32x4 acc[2][2][4][2];
#pragma unroll
    for (int a = 0; a < 2; ++a)
#pragma unroll
        for (int b = 0; b < 2; ++b)
#pragma unroll
            for (int m = 0; m < 4; ++m)
#pragma unroll
                for (int n = 0; n < 2; ++n) acc[a][b][m][n] = (f32x4){0.f, 0.f, 0.f, 0.f};
    bf16x8 At[4][2], B0[2][2], B1[2][2];
    const char* cA = (const char*)g.A + (size_t)cur.pm * tstep; const char* cB = (const char*)g.Bt + (size_t)cur.pn * tstep;
    S.a_ready(cur);
    if constexpr (SP2) {
        PG8_STAGE(PG8_SB(0, 0), cB, voffB); PG8_STAGE(PG8_SB(0, 1), cB + hstep, voffB); PG8_STAGE(PG8_SA(0, 0), cA, voffA); PG8_STAGE(PG8_SA(0, 1), cA + hstep, voffA);
        if (wr == 1) PG8_BAR;
        PG8_WAIT_V(2); PG8_BAR;
        PG8_STAGE(PG8_SB(1, 0), cB + kstep, voffB); PG8_STAGE(PG8_SA(1, 0), cA + kstep, voffA); PG8_STAGE(PG8_SB(1, 1), cB + hstep + kstep, voffB);
        PG8_WAIT_V(6); PG8_BAR;
    } else {
        PG8_STAGE(PG8_SB(0, 0), cB, voffB); PG8_STAGE(PG8_SA(0, 0), cA, voffA); PG8_STAGE(PG8_SB(0, 1), cB + hstep, voffB); PG8_STAGE(PG8_SA(0, 1), cA + hstep, voffA);
        if (wr == 1) PG8_BAR;
        PG8_WAIT_V(4); PG8_BAR;
        PG8_STAGE(PG8_SB(1, 0), cB + kstep, voffB); PG8_STAGE(PG8_SA(1, 0), cA + kstep, voffA); PG8_STAGE(PG8_SB(1, 1), cB + hstep + kstep, voffB);
        PG8_WAIT_V(6); PG8_BAR;
    }
    for (;;) {
        const bool has_next = S.next(ui + 1, nxt);
        const char* nA = has_next ? (const char*)g.A + (size_t)nxt.pm * tstep : cA; const char* nB = has_next ? (const char*)g.Bt + (size_t)nxt.pn * tstep : cB;
        for (int t = 0; t < nt; t += 2) {
            const bool last = (t == nt - 2);
            const char* a1 = cA + (size_t)(t + 1) * kstep;
            const char* a2 = last ? nA : cA + (size_t)(t + 2) * kstep; const char* b2 = last ? nB : cB + (size_t)(t + 2) * kstep;
            const char* a3 = a2 + kstep; const char* b3 = b2 + kstep;
            if (last && has_next) S.a_ready(nxt);
            if constexpr (SP2) {
            PG8_LDB(B0, 0, 0); PG8_LDB(B1, 0, 1); PG8_SCHED; PG8_LDA(At, 0, 0); PG8_STAGE(PG8_SA(1, 1), a1 + hstep, voffA);
            PG8_WAIT_V(8); PG8_WAIT_L(0); PG8_BAR; PG8_MMA(0, 0, At, B0); PG8_MMA(0, 1, At, B1); PG8_BAR; PG8_SCHED;
            PG8_LDA(At, 0, 1); PG8_STAGE(PG8_SB(0, 0), b2, voffB); PG8_STAGE(PG8_SB(0, 1), b2 + hstep, voffB); PG8_STAGE(PG8_SA(0, 0), a2, voffA);
            PG8_WAIT_V(8); PG8_WAIT_L(0); PG8_BAR; PG8_MMA(1, 0, At, B0); PG8_MMA(1, 1, At, B1); PG8_BAR; PG8_SCHED;
            PG8_LDB(B0, 1, 0); PG8_LDB(B1, 1, 1); PG8_SCHED; PG8_LDA(At, 1, 0); PG8_STAGE(PG8_SA(0, 1), a2 + hstep, voffA);
            PG8_WAIT_V(8); PG8_WAIT_L(0); PG8_BAR; PG8_MMA(0, 0, At, B0); PG8_MMA(0, 1, At, B1); PG8_BAR; PG8_SCHED;
            PG8_LDA(At, 1, 1); PG8_STAGE(PG8_SB(1, 0), b3, voffB); PG8_STAGE(PG8_SB(1, 1), b3 + hstep, voffB); PG8_STAGE(PG8_SA(1, 0), a3, voffA);
            PG8_WAIT_V(8); PG8_WAIT_L(0); PG8_BAR; PG8_MMA(1, 0, At, B0); PG8_MMA(1, 1, At, B1); PG8_BAR; PG8_SCHED;
            } else {
            PG8_LDB(B0, 0, 0); PG8_SCHED; PG8_LDA(At, 0, 0); PG8_STAGE(PG8_SA(1, 1), a1 + hstep, voffA);
            PG8_WAIT_L(8); PG8_BAR; PG8_WAIT_L(0); PG8_MMA(0, 0, At, B0); PG8_BAR; PG8_SCHED;
            PG8_LDB(B1, 0, 1); PG8_STAGE(PG8_SB(0, 0), b2, voffB);
            PG8_BAR; PG8_WAIT_L(0); PG8_MMA(0, 1, At, B1); PG8_BAR;
            PG8_LDA(At, 0, 1); PG8_STAGE(PG8_SA(0, 0), a2, voffA);
            PG8_BAR; PG8_WAIT_L(0); PG8_MMA(1, 0, At, B0); PG8_BAR; PG8_SCHED;
            PG8_STAGE(PG8_SB(0, 1), b2 + hstep, voffB);
            PG8_WAIT_V(6); PG8_BAR; PG8_MMA(1, 1, At, B1); PG8_BAR;
            PG8_LDB(B0, 1, 0); PG8_SCHED; PG8_LDA(At, 1, 0); PG8_STAGE(PG8_SA(0, 1), a2 + hstep, voffA);
            PG8_WAIT_L(8); PG8_BAR; PG8_WAIT_L(0); PG8_MMA(0, 0, At, B0); PG8_BAR; PG8_SCHED;
            PG8_LDB(B1, 1, 1); PG8_STAGE(PG8_SB(1, 0), b3, voffB);
            PG8_BAR; PG8_WAIT_L(0); PG8_MMA(0, 1, At, B1); PG8_BAR;
            PG8_LDA(At, 1, 1); PG8_STAGE(PG8_SA(1, 0), a3, voffA);
            PG8_BAR; PG8_WAIT_L(0); PG8_MMA(1, 0, At, B0); PG8_BAR; PG8_SCHED;
            PG8_STAGE(PG8_SB(1, 1), b3 + hstep, voffB);
            PG8_WAIT_V(6); PG8_BAR; PG8_MMA(1, 1, At, B1); PG8_BAR;
            }
        }
        if constexpr (ALIGN_EPI) { if (wr == 0) PG8_BAR; }
        if constexpr (!Epi::AFTER_DRAIN) { E(acc, cur, wr, wc, fr, fq); S.done(cur); }
        if (!has_next) break;
#pragma unroll
        for (int a = 0; a < 2; ++a)
#pragma unroll
            for (int b = 0; b < 2; ++b)
#pragma unroll
                for (int m = 0; m < 4; ++m)
#pragma unroll
                    for (int n = 0; n < 2; ++n) acc[a][b][m][n] = (f32x4){0.f, 0.f, 0.f, 0.f};
        cur = nxt; cA = nA; cB = nB; ++ui;
        if constexpr (ALIGN_EPI) { if (wr == 1) PG8_BAR; }
    }
    PG8_WAIT_V(0);
    if constexpr (!ALIGN_EPI) { if (wr == 0) PG8_BAR; }
    PG8_BAR;
    if constexpr (Epi::AFTER_DRAIN) { E.fused(acc, cur, wr, wc, fr, fq, lds, wid, lane); S.done(cur); }
#undef PG8_SA
#undef PG8_SB
#undef PG8_STAGE
#undef PG8_LDA
#undef PG8_LDB
#undef PG8_MMA
#undef PG8_WAIT_V
#undef PG8_WAIT_L
#undef PG8_BAR
#undef PG8_SCHED
}
}

namespace att {
typedef unsigned short bf16_t;
typedef short bf16x8 __attribute__((ext_vector_type(8)));
typedef short s16x4 __attribute__((ext_vector_type(4)));
typedef float f32x16 __attribute__((ext_vector_type(16)));
typedef float f32x4 __attribute__((ext_vector_type(4)));
typedef unsigned u32x4 __attribute__((ext_vector_type(4)));
typedef unsigned u32x2 __attribute__((ext_vector_type(2)));
#define ALAS __attribute__((address_space(3)))
constexpr int SEQ = 4096, PITCH = 3072, SLOTB = 8192;
constexpr int NSLOT = 3, L_K = 0, L_V = NSLOT * SLOTB, L_CK = 2 * NSLOT * SLOTB, L_FLAG = L_CK + 16384, L_KMAX = L_FLAG + 64, L_RED = L_KMAX + 64, L_END = L_RED + 64;
constexpr float LOG2E = 1.4426950408889634f;
constexpr float FX_DONE = -160.f;
constexpr float SB_DONE = -160.f;
__device__ __forceinline__ int crow(int r, int hi) { return (r & 3) + 8 * (r >> 2) + 4 * hi; }
__device__ __forceinline__ void glds16(const void* gsrc, unsigned lds_dst) { unsigned keep;
    asm volatile("s_mov_b32 %0, m0\n\ts_mov_b32 m0, %2\n\ts_nop 0\n\tglobal_load_lds_dwordx4 %1, off\n\ts_mov_b32 m0, %0" : "=&s"(keep) : "v"(gsrc), "s"(lds_dst) : "memory"); }
typedef float f32x2_t __attribute__((ext_vector_type(2))); typedef __bf16 bf16x2_t __attribute__((ext_vector_type(2)));
__device__ __forceinline__ unsigned cvtpk(float lo, float hi) { f32x2_t v = {lo, hi}; bf16x2_t b = __builtin_convertvector(v, bf16x2_t); return __builtin_bit_cast(unsigned, b); }
typedef short v4i16_t __attribute__((ext_vector_type(4)));
__device__ __forceinline__ s16x4 vtr(const ALAS unsigned char* p) { return __builtin_bit_cast(s16x4, __builtin_amdgcn_ds_read_tr16_b64_v4i16((ALAS v4i16_t*)p)); }
#define ATT_WAIT_BAR(N) asm volatile("s_waitcnt vmcnt(" #N ") lgkmcnt(0)\n\ts_barrier" ::: "memory")
#define ATT_BAR() asm volatile("s_waitcnt lgkmcnt(0)\n\ts_barrier" ::: "memory")


__device__ __forceinline__ void fox_kmax(int b, int h, const bf16_t* K, ALAS unsigned char* shm) {
    const int tid = threadIdx.x, lane = tid & 63, wid = __builtin_amdgcn_readfirstlane(tid >> 6);
    float mx = 0.f;
    for (int r = tid; r < SEQ; r += 512) {
        const bf16_t* kr = K + ((long)b * SEQ + r) * PITCH + h * 64;
        float s = 0.f;
#pragma unroll
        for (int c = 0; c < 8; ++c) { const u32x4 w = *(const u32x4*)(kr + 8 * c);
#pragma unroll
            for (int e = 0; e < 4; ++e) { const float lo = __uint_as_float(w[e] << 16), hi = __uint_as_float(w[e] & 0xffff0000u); s += lo * lo + hi * hi; } }
        mx = fmaxf(mx, s);
    }
#pragma unroll
    for (int o = 1; o < 64; o <<= 1) mx = fmaxf(mx, __shfl_xor(mx, o));
    ALAS float* red = (ALAS float*)(shm + L_RED);
    if (lane == 0) red[wid] = mx;
    __syncthreads();
    if (tid == 0) { float m = red[0];
#pragma unroll
        for (int w = 1; w < 8; ++w) m = fmaxf(m, red[w]);
        *(ALAS float*)(shm + L_KMAX) = sqrtf(m); }
    __syncthreads();
}

template <bool SB>
__device__ __forceinline__ void attn_unit(int b, int h, int qb, const bf16_t* Q, const bf16_t* K, const bf16_t* V, const float* cum, bf16_t* O, ALAS unsigned char* shm) {
    const int tid = threadIdx.x, lane = tid & 63, r32 = lane & 31, hi = lane >> 5;
    const int wid = __builtin_amdgcn_readfirstlane(tid >> 6);
    const long rowbase = (long)b * SEQ; const int q0 = qb * 256;
    const int wq0 = q0 + wid * 32, qrow = wq0 + r32;
    const unsigned lds0 = (unsigned)(uintptr_t)shm;
    ALAS float* ck = (ALAS float*)(shm + L_CK);
    ALAS unsigned* flag = (ALAS unsigned*)(shm + L_FLAG);
    const int NT = (q0 + 256) / 64;
    const bf16_t* ksrc = K + (rowbase + lane) * PITCH + h * 64 + wid * 8;
    const bf16_t* vsrc = V + (rowbase + 16 * (wid & 3) + (lane >> 2)) * PITCH + h * 64 + (wid >> 2) * 32 + (lane & 3) * 8;
    const unsigned kdst = lds0 + L_K + wid * 1024, vdst = lds0 + L_V + wid * 1024;
#define ATT_DMA(t, so) do { glds16(ksrc + (long)(t) * 64 * PITCH, (unsigned)__builtin_amdgcn_readfirstlane(kdst + (so))); glds16(vsrc + (long)(t) * 64 * PITCH, (unsigned)__builtin_amdgcn_readfirstlane(vdst + (so))); } while (0)
    ATT_DMA(NT - 1, 0); ATT_DMA(NT - 2, SLOTB);
    bf16x8 qr[4];
    { const bf16_t* Qw = Q + (rowbase + qrow) * PITCH + h * 64 + hi * 8;
#pragma unroll
      for (int d0 = 0; d0 < 4; ++d0) qr[d0] = *(const bf16x8*)(Qw + d0 * 16); }
    float cq2 = 0.f, qkb = 0.f;
    if (!SB) {
        for (int i = tid; i < q0 + 256; i += 512) ck[i] = cum[i] * LOG2E;
        cq2 = cum[qrow] * LOG2E;
        float s = 0.f;
#pragma unroll
        for (int d0 = 0; d0 < 4; ++d0) { const u32x4 w = __builtin_bit_cast(u32x4, qr[d0]);
#pragma unroll
            for (int e = 0; e < 4; ++e) { const float lo = __uint_as_float(w[e] << 16), hh = __uint_as_float(w[e] & 0xffff0000u); s += lo * lo + hh * hh; } }
        { auto rr = __builtin_amdgcn_permlane32_swap(__float_as_uint(s), __float_as_uint(s), false, false); s = __uint_as_float(rr[0]) + __uint_as_float(rr[1]); }
        qkb = sqrtf(s) * (*(const ALAS float*)(shm + L_KMAX)) * 1.01f + 0.5f;
    }
    f32x16 o0 = {}, o1 = {};
    float mref = 0.f, l_run = 0.f, carry = SB ? 1.f : 0.f;
    bool started = false, wdone = false;
    const ALAS unsigned char* kp0 = shm + L_K + hi * 1024 + r32 * 16;
    const ALAS unsigned char* vp0 = shm + L_V + ((lane >> 4) & 1) * 32 + (lane & 3) * 8 + (4 * hi + ((lane & 15) >> 2)) * 64;
    int so = 0;
    for (int t = NT - 1; t >= 0; --t) {
        if (t > 0) { ATT_WAIT_BAR(2); } else { ATT_WAIT_BAR(0); }
        if (t < NT - 1) {
            const ALAS unsigned* fp = flag + ((t + 1) & 1) * 8;
            const u32x4 f0 = *(const ALAS u32x4*)fp, f1 = *(const ALAS u32x4*)(fp + 4);
            const unsigned all = f0.x & f0.y & f0.z & f0.w & f1.x & f1.y & f1.z & f1.w;
            if (__builtin_amdgcn_readfirstlane(all) != 0u) break;
        }
        if (t >= 2) { const int sn = (so == 0) ? 2 * SLOTB : so - SLOTB; ATT_DMA(t - 2, sn); }
        const int kv0 = 64 * t;
        if (kv0 <= wq0 + 31 && !wdone) {
            const bool needmask = (kv0 + 63 >= wq0);
            const ALAS unsigned char* kp = kp0 + so;
            f32x16 p0, p1;
            if (!SB) {
                const float base = cq2 - mref;
                const ALAS float* ckp = ck + kv0 + 4 * hi;
#pragma unroll
                for (int g = 0; g < 4; ++g) { const f32x4 c0 = *(const ALAS f32x4*)(ckp + 8 * g), c1 = *(const ALAS f32x4*)(ckp + 32 + 8 * g);
#pragma unroll
                    for (int e = 0; e < 4; ++e) { p0[4 * g + e] = base - c0[e]; p1[4 * g + e] = base - c1[e]; } }
            } else { p0 = f32x16{}; p1 = f32x16{}; }
#pragma unroll
            for (int d0 = 0; d0 < 4; ++d0) {
                const bf16x8 b0 = *(const ALAS bf16x8*)(kp + d0 * 2048), b1 = *(const ALAS bf16x8*)(kp + d0 * 2048 + 512);
                p0 = __builtin_amdgcn_mfma_f32_32x32x16_bf16(b0, qr[d0], p0, 0, 0, 0);
                p1 = __builtin_amdgcn_mfma_f32_32x32x16_bf16(b1, qr[d0], p1, 0, 0, 0);
            }
            if (!SB) {
                if (needmask) {
#pragma unroll
                    for (int r = 0; r < 16; ++r) { const int kv = kv0 + crow(r, hi); if (kv > qrow) p0[r] = -INFINITY; if (kv + 32 > qrow) p1[r] = -INFINITY; }
                }
                float mx = fmaxf(fmaxf(p0[0], p1[0]), fmaxf(p0[1], p1[1]));
#pragma unroll
                for (int r = 2; r < 16; r += 2) mx = fmaxf(fmaxf(mx, p0[r]), fmaxf(p1[r], fmaxf(p0[r + 1], p1[r + 1])));
                { auto rr = __builtin_amdgcn_permlane32_swap(__float_as_uint(mx), __float_as_uint(mx), false, false); mx = fmaxf(__uint_as_float(rr[0]), __uint_as_float(rr[1])); }
                if (__any(mx > 0.f) || !started) {
                    const float dl = started ? fmaxf(mx, 0.f) : mx;
                    mref += dl;
                    const float alpha = started ? __builtin_amdgcn_exp2f(-dl) : 0.f;
                    l_run *= alpha;
#pragma unroll
                    for (int r = 0; r < 16; ++r) { p0[r] -= dl; p1[r] -= dl; o0[r] *= alpha; o1[r] *= alpha; }
                    started = true;
                }
                float s0 = 0.f, s1 = 0.f;
#pragma unroll
                for (int r = 0; r < 16; ++r) { p0[r] = __builtin_amdgcn_exp2f(p0[r]); p1[r] = __builtin_amdgcn_exp2f(p1[r]); s0 += p0[r]; s1 += p1[r]; }
                l_run += s0 + s1;
                wdone = __all(qkb + cq2 - ck[kv0] - mref < FX_DONE);
            } else {
                f32x16 K0, K1;
#pragma unroll
                for (int r = 0; r < 16; ++r) {
                    const float e0 = __builtin_amdgcn_exp2f(fminf(p0[r], 120.f)), e1 = __builtin_amdgcn_exp2f(fminf(p1[r], 120.f));
                    float k0 = __builtin_amdgcn_rcpf(1.f + e0), k1 = __builtin_amdgcn_rcpf(1.f + e1);
                    float b0 = e0 * k0, b1 = e1 * k1;
                    if (needmask) { const int kv = kv0 + crow(r, hi); if (kv >= qrow) { k0 = 1.f; b0 = 0.f; } if (kv + 32 >= qrow) { k1 = 1.f; b1 = 0.f; } }
                    K0[r] = k0; K1[r] = k1; p0[r] = b0; p1[r] = b1;
                }
                float lo[8], hv[8];
#pragma unroll
                for (int g = 0; g < 4; ++g) {
                    const float g0 = (K0[4 * g] * K0[4 * g + 1]) * (K0[4 * g + 2] * K0[4 * g + 3]);
                    const float g1 = (K1[4 * g] * K1[4 * g + 1]) * (K1[4 * g + 2] * K1[4 * g + 3]);
                    auto r0 = __builtin_amdgcn_permlane32_swap(__float_as_uint(g0), __float_as_uint(g0), false, false);
                    auto r1 = __builtin_amdgcn_permlane32_swap(__float_as_uint(g1), __float_as_uint(g1), false, false);
                    lo[g] = __uint_as_float(r0[0]); hv[g] = __uint_as_float(r0[1]); lo[4 + g] = __uint_as_float(r1[0]); hv[4 + g] = __uint_as_float(r1[1]);
                }
                float E[8]; float R = carry;
#pragma unroll
                for (int i = 7; i >= 0; --i) { const float eh = R; R *= hv[i]; const float el = R; R *= lo[i]; E[i] = hi ? eh : el; }
                carry = R;
#pragma unroll
                for (int g = 0; g < 4; ++g) {
                    float run0 = E[g], run1 = E[4 + g];
#pragma unroll
                    for (int e = 3; e >= 0; --e) { const int r = 4 * g + e;
                        p0[r] *= run0; p1[r] *= run1; run0 *= K0[r]; run1 *= K1[r]; }
                }
                wdone = __all(carry == 0.f);
            }
            u32x4 w;
            bf16x8 pa[4];
            w = (u32x4){cvtpk(p0[0], p0[1]), cvtpk(p0[2], p0[3]), cvtpk(p0[4], p0[5]), cvtpk(p0[6], p0[7])}; pa[0] = __builtin_bit_cast(bf16x8, w);
            w = (u32x4){cvtpk(p0[8], p0[9]), cvtpk(p0[10], p0[11]), cvtpk(p0[12], p0[13]), cvtpk(p0[14], p0[15])}; pa[1] = __builtin_bit_cast(bf16x8, w);
            w = (u32x4){cvtpk(p1[0], p1[1]), cvtpk(p1[2], p1[3]), cvtpk(p1[4], p1[5]), cvtpk(p1[6], p1[7])}; pa[2] = __builtin_bit_cast(bf16x8, w);
            w = (u32x4){cvtpk(p1[8], p1[9]), cvtpk(p1[10], p1[11]), cvtpk(p1[12], p1[13]), cvtpk(p1[14], p1[15])}; pa[3] = __builtin_bit_cast(bf16x8, w);
            const ALAS unsigned char* vp = vp0 + so;
#pragma unroll
            for (int s = 0; s < 4; ++s) {
                const s16x4 a0 = vtr(vp + s * 1024), a1 = vtr(vp + s * 1024 + 512), c0 = vtr(vp + 4096 + s * 1024), c1 = vtr(vp + 4096 + s * 1024 + 512);
                const bf16x8 v0 = {a0[0], a0[1], a0[2], a0[3], a1[0], a1[1], a1[2], a1[3]}, v1 = {c0[0], c0[1], c0[2], c0[3], c1[0], c1[1], c1[2], c1[3]};
                o0 = __builtin_amdgcn_mfma_f32_32x32x16_bf16(v0, pa[s], o0, 0, 0, 0);
                o1 = __builtin_amdgcn_mfma_f32_32x32x16_bf16(v1, pa[s], o1, 0, 0, 0);
            }
        }
        if (lane == 0) flag[(t & 1) * 8 + wid] = wdone ? 1u : 0u;
        so = (so == 2 * SLOTB) ? 0 : so + SLOTB;
    }
    asm volatile("s_waitcnt vmcnt(0) lgkmcnt(0)\n\ts_barrier" ::: "memory");
    float inv = 1.f;
    if (!SB) { auto rr = __builtin_amdgcn_permlane32_swap(__float_as_uint(l_run), __float_as_uint(l_run), false, false); inv = 1.f / (__uint_as_float(rr[0]) + __uint_as_float(rr[1])); }
    bf16_t* Ow = O + (rowbase + qrow) * 512 + h * 64 + 4 * hi;
#pragma unroll
    for (int g = 0; g < 4; ++g) {
        u32x2 w0, w1;
        w0.x = cvtpk(o0[4 * g] * inv, o0[4 * g + 1] * inv); w0.y = cvtpk(o0[4 * g + 2] * inv, o0[4 * g + 3] * inv);
        w1.x = cvtpk(o1[4 * g] * inv, o1[4 * g + 1] * inv); w1.y = cvtpk(o1[4 * g + 2] * inv, o1[4 * g + 3] * inv);
        *(u32x2*)(Ow + 8 * g) = w0; *(u32x2*)(Ow + 32 + 8 * g) = w1;
    }
#undef ATT_DMA
}
}


#define LAS __attribute__((address_space(3)))
typedef unsigned short bf16;
typedef float f32x4 __attribute__((ext_vector_type(4)));
typedef unsigned u32x4v __attribute__((ext_vector_type(4)));
typedef unsigned u32x2v __attribute__((ext_vector_type(2)));
constexpr int NB = 16, SEQ = 4096, DM = 1024, T = NB * SEQ, DFF = 2816, DINP = 5128, NIN = 5120, NMOD = 6144;
constexpr float RMS_EPS = 1e-6f;
constexpr float QSCALE = 0.125f * 1.4426950408889634f;
constexpr size_t MiB = 1u << 20;
constexpr size_t WS_MOD = 1 * MiB, WS_LOGF = 2 * MiB, WS_CUM = 4 * MiB, WS_WIN = 8 * MiB, WS_WSB = 18 * MiB, WS_WFX = 19 * MiB, WS_WOUT = 20 * MiB, WS_WGU = 22 * MiB, WS_WDN = 34 * MiB;
constexpr size_t WS_H = 64 * MiB, WS_YSB = 192 * MiB, WS_YFX = 256 * MiB, WS_GATES = 320 * MiB, WS_QKV = 576 * MiB, WS_ACT = 576 * MiB, WS_END = 960 * MiB;
constexpr int LDS_BYTES = 147456;
constexpr int NPHASE = 11;

struct Args { const float* in[16]; float* out; unsigned char* ws; int ph_lo, ph_hi; };

__device__ __forceinline__ float wave_sum(float v) {
#pragma unroll
    for (int o = 1; o < 64; o <<= 1) v += __shfl_xor(v, o);
    return v;
}
__device__ __forceinline__ unsigned f2bf(float f) { unsigned u = __builtin_bit_cast(unsigned, f); return (u + 0x7fffu + ((u >> 16) & 1u)) >> 16; }
__device__ __forceinline__ unsigned pk2(float lo, float hi) { return f2bf(lo) | (f2bf(hi) << 16); }

__device__ __forceinline__ void transpose_item(const float* W, int ldw, int K, int src_col0, bf16* WT, int dst_row0, int k0, LAS float* scr, int lane) {
#pragma unroll 8
    for (int i = 0; i < 32; ++i) { const int kk = 2 * i + (lane >> 5); scr[kk * 33 + (lane & 31)] = W[(size_t)(k0 + kk) * ldw + src_col0 + (lane & 31)]; }
    asm volatile("s_waitcnt lgkmcnt(0)" ::: "memory");
    const int c = lane & 7;
#pragma unroll
    for (int j = 0; j < 4; ++j) { const int n = (lane >> 3) + 8 * j; const LAS float* s = scr + (8 * c) * 33 + n;
        u32x4v o; o.x = pk2(s[0 * 33], s[1 * 33]); o.y = pk2(s[2 * 33], s[3 * 33]); o.z = pk2(s[4 * 33], s[5 * 33]); o.w = pk2(s[6 * 33], s[7 * 33]);
        *(u32x4v*)(WT + (size_t)(dst_row0 + n) * K + k0 + 8 * c) = o; }
    asm volatile("s_waitcnt lgkmcnt(0)" ::: "memory");
}

__device__ __forceinline__ void phase_prologue(const Args& a, LAS unsigned char* lds, int tid, int lane, int wave, int G) {
    unsigned char* ws = a.ws;
    float* mod = (float*)(ws + WS_MOD);
    for (int item = blockIdx.x; item < NMOD / 64; item += G) {
        LAS float* sc = (LAS float*)lds;
        LAS float* red = (LAS float*)(lds + 65536);
        const float* c = a.in[1];
        for (int i = tid; i < NB * DM; i += 512) { const int b = i >> 10, k = i & 1023; const float v = c[i]; sc[k * 16 + b] = v / (1.f + __expf(-v)); }
        __syncthreads();
        const float* w = a.in[2] + item * 64 + lane;
        float acc[16];
#pragma unroll
        for (int b = 0; b < 16; ++b) acc[b] = 0.f;
        const int k0 = wave * 128;
#pragma unroll 4
        for (int k = k0; k < k0 + 128; ++k) {
            const float wv = w[(size_t)k * NMOD];
            const LAS f32x4* s4 = (const LAS f32x4*)(sc + k * 16);
#pragma unroll
            for (int q = 0; q < 4; ++q) { const f32x4 s = s4[q]; acc[4 * q] += s.x * wv; acc[4 * q + 1] += s.y * wv; acc[4 * q + 2] += s.z * wv; acc[4 * q + 3] += s.w * wv; }
        }
#pragma unroll
        for (int b = 0; b < 16; ++b) red[(wave * 16 + b) * 64 + lane] = acc[b];
        __syncthreads();
        for (int o = tid; o < 1024; o += 512) { const int b = o >> 6, l = o & 63; float s = 0.f;
#pragma unroll
            for (int w8 = 0; w8 < 8; ++w8) s += red[(w8 * 16 + b) * 64 + l];
            mod[b * NMOD + item * 64 + l] = s + a.in[3][item * 64 + l]; }
        __syncthreads();
    }
    LAS float* scr = (LAS float*)(lds + wave * 16384);
    const int gw = blockIdx.x * 8 + wave, NGW = G * 8;
    bf16* WIN = (bf16*)(ws + WS_WIN); bf16* WSB = (bf16*)(ws + WS_WSB); bf16* WFX = (bf16*)(ws + WS_WFX); bf16* WOUT = (bf16*)(ws + WS_WOUT); bf16* WGU = (bf16*)(ws + WS_WGU); bf16* WDN = (bf16*)(ws + WS_WDN);
    constexpr int I0 = 16 * 96, I1 = 16 * 64, I2 = 8 * 32, I3 = 8 * 32, I4 = 16 * 32, I5 = 16 * 88, I6 = 16 * 88, I7 = 44 * 32;
    constexpr int NITEMS = I0 + I1 + I2 + I3 + I4 + I5 + I6 + I7;
    for (int it = gw; it < NITEMS; it += NGW) {
        int r = it;
        if (r < I0) { const int kb = r / 96, nb = r % 96; transpose_item(a.in[5], DINP, 1024, 32 * nb, WIN, 32 * nb, 64 * kb, scr, lane); continue; } r -= I0;
        if (r < I1) { const int kb = r / 64, nb = r % 64; transpose_item(a.in[5], DINP, 1024, 3080 + 32 * nb, WIN, 3072 + 32 * nb, 64 * kb, scr, lane); continue; } r -= I1;
        if (r < I2) { const int kb = r / 32, nb = r % 32; transpose_item(a.in[8], 1024, 512, 32 * nb, WSB, 32 * nb, 64 * kb, scr, lane); continue; } r -= I2;
        if (r < I3) { const int kb = r / 32, nb = r % 32; transpose_item(a.in[9], 1024, 512, 32 * nb, WFX, 32 * nb, 64 * kb, scr, lane); continue; } r -= I3;
        if (r < I4) { const int kb = r / 32, nb = r % 32; transpose_item(a.in[10], 1024, 1024, 32 * nb, WOUT, 32 * nb, 64 * kb, scr, lane); continue; } r -= I4;
        if (r < I5) { const int kb = r / 88, nb = r % 88, n0 = 32 * nb; transpose_item(a.in[12], DFF, 1024, n0, WGU, (n0 >> 7) * 256 + (n0 & 127), 64 * kb, scr, lane); continue; } r -= I5;
        if (r < I6) { const int kb = r / 88, nb = r % 88, n0 = 32 * nb; transpose_item(a.in[13], DFF, 1024, n0, WGU, (n0 >> 7) * 256 + 128 + (n0 & 127), 64 * kb, scr, lane); continue; } r -= I6;
        { const int kb = r / 32, nb = r % 32; transpose_item(a.in[14], 1024, DFF, 32 * nb, WDN, 32 * nb, 64 * kb, scr, lane); }
    }
}

template <int MODE>
__device__ __forceinline__ void norm_pass(const Args& a, LAS unsigned char* lds, int tid, int lane, int wave, int G) {
    unsigned char* ws = a.ws;
    const float* mod = (const float*)(ws + WS_MOD);
    const float* src = MODE == 0 ? a.in[0] : a.out;
    const float* gvec = MODE == 0 ? a.in[4] : (MODE == 1 ? a.in[11] : a.in[15]);
    constexpr int SH = MODE == 0 ? 0 : 3 * DM, SC = MODE == 0 ? DM : 4 * DM;
    bf16* H = (bf16*)(ws + WS_H);
    float* LOGF = (float*)(ws + WS_LOGF);
    LAS float* wfL = (LAS float*)lds;
    if (MODE == 0) {
        for (int i = tid; i < 8192; i += 512) { const int jj = i >> 10, k = i & 1023; wfL[i] = a.in[5][(size_t)k * DINP + 3072 + jj]; }
        __syncthreads();
    }
    const int gw = blockIdx.x * 8 + wave, NGW = G * 8;
    for (int r0 = gw * 32; r0 < T; r0 += NGW * 32) {
        const int b = r0 >> 12;
        f32x4 gs[4], sh[4];
#pragma unroll
        for (int j = 0; j < 4; ++j) { const int col = 4 * lane + 256 * j; const f32x4 g4 = *(const f32x4*)(gvec + col);
            if (MODE < 2) { const f32x4 s4 = *(const f32x4*)(mod + b * NMOD + SC + col); sh[j] = *(const f32x4*)(mod + b * NMOD + SH + col); gs[j] = g4 * (1.f + s4); }
            else { gs[j] = g4; sh[j] = (f32x4){0.f, 0.f, 0.f, 0.f}; } }
        f32x4 vn[4];
        { const f32x4* xr = (const f32x4*)(src + (size_t)r0 * DM) + lane;
#pragma unroll
          for (int j = 0; j < 4; ++j) vn[j] = xr[64 * j]; }
        for (int rr = 0; rr < 32; ++rr) {
            const size_t row = (size_t)r0 + rr;
            f32x4 v[4];
#pragma unroll
            for (int j = 0; j < 4; ++j) v[j] = vn[j];
            if (rr < 31) { const f32x4* xr = (const f32x4*)(src + (row + 1) * DM) + lane;
#pragma unroll
                for (int j = 0; j < 4; ++j) vn[j] = xr[64 * j]; }
            float ss = 0.f;
#pragma unroll
            for (int j = 0; j < 4; ++j) ss += (v[j].x * v[j].x + v[j].y * v[j].y) + (v[j].z * v[j].z + v[j].w * v[j].w);
            ss = wave_sum(ss);
            const float rstd = 1.0f / sqrtf(ss * (1.0f / DM) + RMS_EPS);
#pragma unroll
            for (int j = 0; j < 4; ++j) v[j] = v[j] * rstd * gs[j] + sh[j];
            if (MODE == 2) { f32x4* o = (f32x4*)(a.out + row * DM) + lane;
#pragma unroll
                for (int j = 0; j < 4; ++j) o[64 * j] = v[j]; }
            else { u32x2v* o = (u32x2v*)(H + row * DM) + lane;
#pragma unroll
                for (int j = 0; j < 4; ++j) { u32x2v w; w.x = pk2(v[j].x, v[j].y); w.y = pk2(v[j].z, v[j].w); o[64 * j] = w; } }
            if (MODE == 0) {
                float f[8];
#pragma unroll
                for (int jj = 0; jj < 8; ++jj) { float s = 0.f;
#pragma unroll
                    for (int j = 0; j < 4; ++j) { const f32x4 w4 = *(const LAS f32x4*)(wfL + jj * 1024 + 4 * lane + 256 * j); s += (v[j].x * w4.x + v[j].y * w4.y) + (v[j].z * w4.z + v[j].w * w4.w); }
                    f[jj] = s; }
                const bool h5 = (lane & 32) != 0, h4 = (lane & 16) != 0, h3 = (lane & 8) != 0;
#pragma unroll
                for (int i = 0; i < 4; ++i) { const float send = h5 ? f[i] : f[i + 4], keep = h5 ? f[i + 4] : f[i]; f[i] = keep + __shfl_xor(send, 32); }
#pragma unroll
                for (int i = 0; i < 2; ++i) { const float send = h4 ? f[i] : f[i + 2], keep = h4 ? f[i + 2] : f[i]; f[i] = keep + __shfl_xor(send, 16); }
                { const float send = h3 ? f[0] : f[1], keep = h3 ? f[1] : f[0]; f[0] = keep + __shfl_xor(send, 8); }
                f[0] += __shfl_xor(f[0], 4); f[0] += __shfl_xor(f[0], 2); f[0] += __shfl_xor(f[0], 1);
                if ((lane & 7) == 0) { const int jj = lane >> 3; const float val = f[0] + a.in[6][jj];
                    LOGF[((size_t)(b * 8 + jj) << 12) + (row & 4095)] = fminf(val, 0.f) - log1pf(__expf(-fabsf(val))); }
            }
        }
    }
}

__device__ __forceinline__ void scan_phase(const Args& a, LAS unsigned char* lds, int tid, int lane, int wave, int G) {
    const float* LOGF = (const float*)(a.ws + WS_LOGF); float* CUM = (float*)(a.ws + WS_CUM);
    LAS float* wt = (LAS float*)lds;
    for (int bh = blockIdx.x; bh < 128; bh += G) {
        const f32x4* src = (const f32x4*)(LOGF + (size_t)bh * SEQ + tid * 8);
        f32x4 a0 = src[0], a1 = src[1];
        a0.y += a0.x; a0.z += a0.y; a0.w += a0.z; a1.x += a0.w; a1.y += a1.x; a1.z += a1.y; a1.w += a1.z;
        const float tot = a1.w; float sc = tot;
#pragma unroll
        for (int o = 1; o < 64; o <<= 1) { const float n = __shfl_up(sc, o); if (lane >= o) sc += n; }
        if (lane == 63) wt[wave] = sc;
        __syncthreads();
        float off = sc - tot;
        for (int w8 = 0; w8 < wave; ++w8) off += wt[w8];
        a0 += off; a1 += off;
        f32x4* dst = (f32x4*)(CUM + (size_t)bh * SEQ + tid * 8);
        dst[0] = a0; dst[1] = a1;
        __syncthreads();
    }
}

__device__ __forceinline__ void dbg_dump(const Args& a, const bf16* src, int pitch, int col0, int tid, int G) {
    for (size_t i = (size_t)blockIdx.x * 512 + tid; i < (size_t)T * DM; i += (size_t)G * 512) { const size_t t = i >> 10; const int c = (int)(i & 1023);
        a.out[i] = __uint_as_float((unsigned)src[t * pitch + col0 + c] << 16); }
}
__global__ void __launch_bounds__(512, 2) mega_fwd(Args a) {
    extern __shared__ __attribute__((aligned(16))) unsigned char lds_raw[];
    LAS unsigned char* lds = (LAS unsigned char*)lds_raw;
    cg::grid_group grid = cg::this_grid();
    const int tid = threadIdx.x, lane = tid & 63, wave = __builtin_amdgcn_readfirstlane(tid >> 6);
    const int G = gridDim.x, bx = blockIdx.x;
    unsigned char* ws = a.ws;
    const int lo = a.ph_lo, hi = a.ph_hi;
#define IN(k) (lo <= (k) && (k) < hi)
#define SEAM(k) do { if (IN(k) && IN((k) + 1)) { asm volatile("s_waitcnt vmcnt(0) lgkmcnt(0)" ::: "memory"); __syncthreads(); grid.sync(); asm volatile("s_waitcnt vmcnt(0)" ::: "memory"); __syncthreads(); } } while (0)
    bf16* H = (bf16*)(ws + WS_H); bf16* QKV = (bf16*)(ws + WS_QKV); bf16* GATES = (bf16*)(ws + WS_GATES); bf16* YSB = (bf16*)(ws + WS_YSB); bf16* YFX = (bf16*)(ws + WS_YFX); bf16* ACT = (bf16*)(ws + WS_ACT);
    const float* mod = (const float*)(ws + WS_MOD);

    if (IN(0)) phase_prologue(a, lds, tid, lane, wave, G);
    SEAM(0);
#ifndef DUP_P1
#define DUP_P1 1
#endif
    if (IN(1)) for (int rep_ = 0; rep_ < DUP_P1; ++rep_) norm_pass<0>(a, lds, tid, lane, wave, G);
    SEAM(1);
#if defined(DBG_DUMP) && DBG_DUMP == 1
    dbg_dump(a, H, 1024, 0, tid, G); return;
#endif
    if (IN(2)) {
        scan_phase(a, lds, tid, lane, wave, G);
        pg8::Gemm g{H, (const bf16*)(ws + WS_WIN), T, NIN, DM}; pg8::StaticOrder S; S.init(T, NIN, G, bx);
        pg8::EpiIn E{QKV, GATES, a.in[7], QSCALE};
        pg8::gemm_phase<pg8::EpiIn, pg8::StaticOrder, true, true>(lds, g, S, E);
    }
    SEAM(2);
#if defined(DBG_DUMP) && DBG_DUMP == 2
    dbg_dump(a, QKV, 3072, 0, tid, G); return;
#endif
#if defined(DBG_DUMP) && DBG_DUMP == 3
    dbg_dump(a, QKV, 3072, 2048, tid, G); return;
#endif
#if defined(DBG_DUMP) && DBG_DUMP == 4
    dbg_dump(a, GATES, 2048, 0, tid, G); return;
#endif
#ifndef DUP_ATT
#define DUP_ATT 1
#endif
    if (IN(3)) for (int rep_ = 0; rep_ < DUP_ATT; ++rep_) {
        const int vcu = (G % 8 == 0) ? (bx % 8) * (G / 8) + bx / 8 : bx;
        const float* CUM = (const float*)(ws + WS_CUM);
        for (int vc = vcu; vc < 256; vc += G) {
            const int bh = vc >> 1, half = vc & 1, b = bh >> 3, h = bh & 7;
#ifdef DBG_COPYV
            { for (int i = tid; i < 4096 * 64 / 8; i += 512) { const int row = i >> 3, ch = i & 7;
                *(u32x4v*)(YSB + ((size_t)b * SEQ + row) * 512 + h * 64 + ch * 8) = *(const u32x4v*)(QKV + ((size_t)b * SEQ + row) * 3072 + 1024 + h * 64 + ch * 8);
                *(u32x4v*)(YFX + ((size_t)b * SEQ + row) * 512 + h * 64 + ch * 8) = *(const u32x4v*)(QKV + ((size_t)b * SEQ + row) * 3072 + 2560 + h * 64 + ch * 8); } continue; }
#endif
#ifdef DBG_NOATT
            { for (int i = tid; i < 4096 * 64 / 8; i += 512) { const int row = i >> 3, ch = i & 7; u32x4v z = {0u, 0u, 0u, 0u};
                *(u32x4v*)(YSB + ((size_t)b * SEQ + row) * 512 + h * 64 + ch * 8) = z; *(u32x4v*)(YFX + ((size_t)b * SEQ + row) * 512 + h * 64 + ch * 8) = z; } continue; }
#endif
            att::fox_kmax(b, h, QKV + 2048, lds);
#ifndef DUP_FX
#define DUP_FX 1
#endif
            for (int rf_ = 0; rf_ < DUP_FX; ++rf_)
            for (int i = 0; i < 8; ++i) { const int s = 2 * (i >> 1) + half, qb = (i & 1) ? 15 - s : s;
                att::attn_unit<false>(b, h, qb, QKV + 1536, QKV + 2048, QKV + 2560, CUM + (size_t)bh * SEQ, YFX, lds); }
            for (int i = 0; i < 8; ++i) { const int s = 2 * (i >> 1) + half, qb = (i & 1) ? 15 - s : s;
                att::attn_unit<true>(b, h, qb, QKV, QKV + 512, QKV + 1024, nullptr, YSB, lds); }
#ifdef DBG_ZERO_SB
            __syncthreads();
            { for (int i = tid; i < 4096 * 64 / 8; i += 512) { const int row = i >> 3, ch = i & 7; u32x4v z = {0u, 0u, 0u, 0u};
                *(u32x4v*)(YSB + ((size_t)b * SEQ + row) * 512 + h * 64 + ch * 8) = z; } }
#endif
#ifdef DBG_ZERO_FX
            __syncthreads();
            { for (int i = tid; i < 4096 * 64 / 8; i += 512) { const int row = i >> 3, ch = i & 7; u32x4v z = {0u, 0u, 0u, 0u};
                *(u32x4v*)(YFX + ((size_t)b * SEQ + row) * 512 + h * 64 + ch * 8) = z; } }
#endif
        }
    }
    SEAM(3);
    if (IN(4)) {
        pg8::Gemm g{YSB, (const bf16*)(ws + WS_WSB), T, DM, 512}; pg8::StaticOrder S; S.init(T, DM, G, bx);
        pg8::EpiBranch<true> E{H, GATES, 0};
        pg8::gemm_phase<pg8::EpiBranch<true>, pg8::StaticOrder, true, true>(lds, g, S, E);
    }
#ifdef DBG_NOP5
    if (false) {
#else
    if (IN(5)) {
#endif
        pg8::Gemm g{YFX, (const bf16*)(ws + WS_WFX), T, DM, 512}; pg8::StaticOrder S; S.init(T, DM, G, bx);
        pg8::EpiBranch<false> E{H, GATES, 1024};
        pg8::gemm_phase<pg8::EpiBranch<false>, pg8::StaticOrder, true, true>(lds, g, S, E);
    }
    SEAM(5);
#if defined(DBG_DUMP) && DBG_DUMP == 5
    dbg_dump(a, H, 1024, 0, tid, G); return;
#endif
    if (IN(6)) {
        pg8::Gemm g{H, (const bf16*)(ws + WS_WOUT), T, DM, DM}; pg8::StaticOrder S; S.init(T, DM, G, bx);
        pg8::EpiResid E{a.in[0], a.out, mod + 2 * DM};
        pg8::gemm_phase<pg8::EpiResid, pg8::StaticOrder, true, true>(lds, g, S, E);
    }
    SEAM(6);
    if (IN(7)) norm_pass<1>(a, lds, tid, lane, wave, G);
    SEAM(7);
#ifndef DUP_P8
#define DUP_P8 1
#endif
    if (IN(8)) for (int rep_ = 0; rep_ < DUP_P8; ++rep_) {
        pg8::Gemm g{H, (const bf16*)(ws + WS_WGU), T, 2 * DFF, DM}; pg8::StaticOrder S; S.init(T, 2 * DFF, G, bx);
        pg8::EpiSwiglu E{ACT};
        pg8::gemm_phase<pg8::EpiSwiglu, pg8::StaticOrder, true, true>(lds, g, S, E);
    }
    SEAM(8);
    if (IN(9)) {
        pg8::Gemm g{ACT, (const bf16*)(ws + WS_WDN), T, DM, DFF}; pg8::StaticOrder S; S.init(T, DM, G, bx);
        pg8::EpiResid E{a.out, a.out, mod + 5 * DM};
        pg8::gemm_phase<pg8::EpiResid, pg8::StaticOrder, true, true>(lds, g, S, E);
    }
    SEAM(9);
    if (IN(10)) norm_pass<2>(a, lds, tid, lane, wave, G);
#undef IN
#undef SEAM
}

extern "C" void kernel_launch(void* const* d_in, const int* in_sizes, int n_in, void* d_out, int out_size, void* d_ws, size_t ws_size, hipStream_t stream) {
    static int grid = 0;
    if (grid == 0) {
        if (n_in != 16 || in_sizes[0] != T * DM || out_size != T * DM || ws_size < WS_END) { fprintf(stderr, "kernel_launch: unexpected shapes (n_in %d, in0 %d, out %d, ws %zu)\n", n_in, n_in > 0 ? in_sizes[0] : -1, out_size, ws_size); grid = -1; return; }
        int dev = 0, cus = 0, per_cu = 0;
        if (hipGetDevice(&dev) != hipSuccess || hipDeviceGetAttribute(&cus, hipDeviceAttributeMultiprocessorCount, dev) != hipSuccess) { grid = -1; return; }
        if (hipFuncSetAttribute((const void*)mega_fwd, hipFuncAttributeMaxDynamicSharedMemorySize, LDS_BYTES) != hipSuccess) { fprintf(stderr, "kernel_launch: hipFuncSetAttribute failed\n"); grid = -1; return; }
        if (hipOccupancyMaxActiveBlocksPerMultiprocessor(&per_cu, (const void*)mega_fwd, 512, LDS_BYTES) != hipSuccess || per_cu < 1) { fprintf(stderr, "kernel_launch: occupancy query says %d\n", per_cu); per_cu = 1; }
        (void)hipGetLastError();
        grid = cus * per_cu;
    }
    if (grid < 0) return;
    Args a{};
    for (int i = 0; i < 16; ++i) a.in[i] = (const float*)d_in[i];
    a.out = (float*)d_out; a.ws = (unsigned char*)d_ws;
#ifndef MK_SPLIT
#define MK_SPLIT 0
#endif
    for (int p0 = 0; p0 < NPHASE; p0 += (MK_SPLIT ? 1 : NPHASE)) {
        a.ph_lo = p0; a.ph_hi = MK_SPLIT ? p0 + 1 : NPHASE;
        void* args[] = {&a};
        const hipError_t e = hipLaunchCooperativeKernel((const void*)mega_fwd, dim3(grid), dim3(512), args, LDS_BYTES, stream);
        if (e != hipSuccess) fprintf(stderr, "kernel_launch: cooperative launch failed: %s (grid %d)\n", hipGetErrorString(e), grid);
    }
}
```

```cpp
#include <hip/hip_runtime.h>
#include <hip/hip_cooperative_groups.h>
#include <cstdio>
#include <cstdint>
namespace cg = cooperative_groups;
namespace pg8 {
#define PG8_LAS __attribute__((address_space(3)))
typedef unsigned short bf16_t;
typedef short bf16x8 __attribute__((ext_vector_type(8)));
typedef float f32x4 __attribute__((ext_vector_type(4)));
typedef unsigned u32x4 __attribute__((ext_vector_type(4)));
constexpr int BM = 256, BK = 64, HALF = 128, HTB = HALF * BK * 2  , STAGE_BYTES = 8 * HTB, NXCD = 8, WGM = 8;

__host__ __device__ __forceinline__ int lds_byte(int r, int c) { const int st = (r >> 4) * 2 + (c >> 5), rr = r & 15, cc = c & 31, ob = rr * 64 + cc * 2; return st * 1024 + (ob ^ (((ob >> 9) & 1) << 5)); }
__host__ __device__ __forceinline__ void stage_rc(int b, int& R, int& C) { const int st = b / 1024, sb = b % 1024, swz = sb ^ (((sb >> 9) & 1) << 5); R = (st >> 1) * 16 + swz / 64; C = (st & 1) * 32 + (swz % 64) / 2; }
__host__ __device__ __forceinline__ int perm32(int rho) { const int n = rho >> 4, i = rho & 15; return 8 * (i >> 2) + 4 * n + (i & 3); }

struct Unit { int pm, pn; };
struct Gemm { const bf16_t* A; const bf16_t* Bt; int M, N, K; };

struct StaticOrder {
    int nM, nN, nwg, G, c;
    __host__ __device__ void init(int M, int N, int G_, int c_) { nM = M / BM; nN = N / BM; nwg = nM * nN; G = G_; c = c_; }
    __host__ __device__ bool next(int i, Unit& u) const {
        const long L = (long)i * G + c; if (L >= nwg) return false;
        int wgid = (int)L; { const int q = nwg / NXCD, r = nwg % NXCD, xcd = wgid % NXCD, off = wgid / NXCD; wgid = (xcd < r ? xcd * (q + 1) : r * (q + 1) + (xcd - r) * q) + off; }
        const int nig = WGM * nN, gid = wgid / nig, fm = gid * WGM, gsz = (nM - fm) < WGM ? (nM - fm) : WGM;
        u.pm = fm + ((wgid % nig) % gsz); u.pn = (wgid % nig) / gsz; return true;
    }
    __device__ __forceinline__ void a_ready(const Unit&) const {}
    __device__ __forceinline__ void done(const Unit&) const {}
};

typedef float f32x2_cv __attribute__((ext_vector_type(2))); typedef __bf16 bf16x2_cv __attribute__((ext_vector_type(2)));
__device__ __forceinline__ unsigned cvt_pk_bf16(float lo, float hi) { f32x2_cv v = {lo, hi}; bf16x2_cv b = __builtin_convertvector(v, bf16x2_cv); return __builtin_bit_cast(unsigned, b); }
typedef unsigned u32x2 __attribute__((ext_vector_type(2)));
__device__ __forceinline__ float bf_lo(unsigned w) { return __uint_as_float(w << 16); }
__device__ __forceinline__ float bf_hi(unsigned w) { return __uint_as_float(w & 0xffff0000u); }
__device__ __forceinline__ float fast_sigmoid(float x) { return __builtin_amdgcn_rcpf(1.f + __builtin_amdgcn_exp2f(-1.4426950409f * x)); }
__device__ __forceinline__ u32x4 pack8(f32x4 v0, f32x4 v1) { u32x4 w; w.x = cvt_pk_bf16(v0[0], v0[1]); w.y = cvt_pk_bf16(v0[2], v0[3]); w.z = cvt_pk_bf16(v1[0], v1[1]); w.w = cvt_pk_bf16(v1[2], v1[3]); return w; }

struct EpiIn {
    static constexpr bool PERM = true, AFTER_DRAIN = false;
    bf16_t* qkv; bf16_t* gates; const float* b_gate; float qscale;
    __device__ __forceinline__ void operator()(const f32x4 (&acc)[2][2][4][2], const Unit& u, int wr, int wc, int fr, int fq) const {
        const int row0 = u.pm * BM + wr * 64 + fr;
        if (u.pn < 12) {
            const float sc = (u.pn < 2 || (u.pn >= 6 && u.pn < 8)) ? qscale : 1.f;
            const int col0 = u.pn * BM + wc * 32 + 8 * fq;
#pragma unroll
            for (int ai = 0; ai < 2; ++ai)
#pragma unroll
                for (int m = 0; m < 4; ++m) { bf16_t* rowp = qkv + (size_t)(row0 + ai * HALF + m * 16) * 3072 + col0;
#pragma unroll
                    for (int bj = 0; bj < 2; ++bj) *(u32x4*)(rowp + bj * HALF) = pack8(acc[ai][bj][m][0] * sc, acc[ai][bj][m][1] * sc); }
        } else {
            const int col0 = (u.pn - 12) * BM + wc * 32 + 8 * fq;
            f32x4 bv[2][2];
#pragma unroll
            for (int bj = 0; bj < 2; ++bj)
#pragma unroll
                for (int n = 0; n < 2; ++n) bv[bj][n] = *(const f32x4*)(b_gate + col0 + bj * HALF + 4 * n);
#pragma unroll
            for (int ai = 0; ai < 2; ++ai)
#pragma unroll
                for (int m = 0; m < 4; ++m) { bf16_t* rowp = gates + (size_t)(row0 + ai * HALF + m * 16) * 2048 + col0;
#pragma unroll
                    for (int bj = 0; bj < 2; ++bj) { f32x4 v0 = acc[ai][bj][m][0] + bv[bj][0], v1 = acc[ai][bj][m][1] + bv[bj][1];
#ifndef DBG_NOSIG
#pragma unroll
                        for (int e = 0; e < 4; ++e) { v0[e] = fast_sigmoid(v0[e]); v1[e] = fast_sigmoid(v1[e]); }
#endif
                        *(u32x4*)(rowp + bj * HALF) = pack8(v0, v1); } }
        }
    }
};
template <bool FIRST> struct EpiBranch {
    static constexpr bool PERM = true, AFTER_DRAIN = false;
    bf16_t* merged; const bf16_t* gates; int goff;
    __device__ __forceinline__ void operator()(const f32x4 (&acc)[2][2][4][2], const Unit& u, int wr, int wc, int fr, int fq) const {
        const int row0 = u.pm * BM + wr * 64 + fr, col0 = u.pn * BM + wc * 32 + 8 * fq;
#pragma unroll
        for (int ai = 0; ai < 2; ++ai)
#pragma unroll
            for (int m = 0; m < 4; ++m) { const size_t row = (size_t)(row0 + ai * HALF + m * 16);
#pragma unroll
                for (int bj = 0; bj < 2; ++bj) { const int c = col0 + bj * HALF;
                    const u32x4 gw = *(const u32x4*)(gates + row * 2048 + goff + c);
                    f32x4 g0 = {bf_lo(gw.x), bf_hi(gw.x), bf_lo(gw.y), bf_hi(gw.y)}, g1 = {bf_lo(gw.z), bf_hi(gw.z), bf_lo(gw.w), bf_hi(gw.w)};
                    f32x4 v0 = g0 * acc[ai][bj][m][0], v1 = g1 * acc[ai][bj][m][1];
                    if (!FIRST) { const u32x4 pw = *(const u32x4*)(merged + row * 1024 + c);
                        v0 += (f32x4){bf_lo(pw.x), bf_hi(pw.x), bf_lo(pw.y), bf_hi(pw.y)}; v1 += (f32x4){bf_lo(pw.z), bf_hi(pw.z), bf_lo(pw.w), bf_hi(pw.w)}; }
                    *(u32x4*)(merged + row * 1024 + c) = pack8(v0, v1); } }
    }
};
struct EpiResid {
    static constexpr bool PERM = false, AFTER_DRAIN = false;
    const float* base; float* out; const float* gate;
    __device__ __forceinline__ void operator()(const f32x4 (&acc)[2][2][4][2], const Unit& u, int wr, int wc, int fr, int fq) const {
        const int row0 = u.pm * BM + wr * 64 + fr, col0 = u.pn * BM + wc * 32 + 4 * fq, b = (u.pm * BM) >> 12;
        f32x4 gv[2][2];
#pragma unroll
        for (int bj = 0; bj < 2; ++bj)
#pragma unroll
            for (int n = 0; n < 2; ++n) gv[bj][n] = *(const f32x4*)(gate + (size_t)b * 6144 + col0 + bj * HALF + n * 16);
#pragma unroll
        for (int ai = 0; ai < 2; ++ai)
#pragma unroll
            for (int m = 0; m < 4; ++m) { const size_t off = (size_t)(row0 + ai * HALF + m * 16) * 1024 + col0;
#pragma unroll
                for (int bj = 0; bj < 2; ++bj)
#pragma unroll
                    for (int n = 0; n < 2; ++n) { const f32x4 bs = *(const f32x4*)(base + off + bj * HALF + n * 16);
                        *(f32x4*)(out + off + bj * HALF + n * 16) = bs + gv[bj][n] * acc[ai][bj][m][n]; } }
    }
};
template <bool BF_BASE> struct EpiResidBf {
    static constexpr bool PERM = true, AFTER_DRAIN = false;
    const float* basef; const bf16_t* baseb; bf16_t* out; const float* gate;
    __device__ __forceinline__ void operator()(const f32x4 (&acc)[2][2][4][2], const Unit& u, int wr, int wc, int fr, int fq) const {
        const int row0 = u.pm * BM + wr * 64 + fr, col0 = u.pn * BM + wc * 32 + 8 * fq, b = (u.pm * BM) >> 12;
        f32x4 gv[2][2];
#pragma unroll
        for (int bj = 0; bj < 2; ++bj)
#pragma unroll
            for (int n = 0; n < 2; ++n) gv[bj][n] = *(const f32x4*)(gate + (size_t)b * 6144 + col0 + bj * HALF + 4 * n);
#pragma unroll
        for (int ai = 0; ai < 2; ++ai)
#pragma unroll
            for (int m = 0; m < 4; ++m) { const size_t off = (size_t)(row0 + ai * HALF + m * 16) * 1024 + col0;
#pragma unroll
                for (int bj = 0; bj < 2; ++bj) { f32x4 v0 = gv[bj][0] * acc[ai][bj][m][0], v1 = gv[bj][1] * acc[ai][bj][m][1];
                    if (BF_BASE) { const u32x4 w = *(const u32x4*)(baseb + off + bj * HALF);
                        v0 += (f32x4){bf_lo(w.x), bf_hi(w.x), bf_lo(w.y), bf_hi(w.y)}; v1 += (f32x4){bf_lo(w.z), bf_hi(w.z), bf_lo(w.w), bf_hi(w.w)}; }
                    else { v0 += *(const f32x4*)(basef + off + bj * HALF); v1 += *(const f32x4*)(basef + off + bj * HALF + 4); }
                    *(u32x4*)(out + off + bj * HALF) = pack8(v0, v1); } }
    }
};
struct EpiSwiglu {
    static constexpr bool PERM = true, AFTER_DRAIN = false;
    bf16_t* A;
    __device__ __forceinline__ void operator()(const f32x4 (&acc)[2][2][4][2], const Unit& u, int wr, int wc, int fr, int fq) const {
        const int row0 = u.pm * BM + wr * 64 + fr, col0 = u.pn * HALF + wc * 32 + 8 * fq;
#pragma unroll
        for (int ai = 0; ai < 2; ++ai)
#pragma unroll
            for (int m = 0; m < 4; ++m) { bf16_t* rowp = A + (size_t)(row0 + ai * HALF + m * 16) * 2816 + col0;
                f32x4 r0, r1;
#pragma unroll
                for (int e = 0; e < 4; ++e) { const float g0 = acc[ai][0][m][0][e], g1 = acc[ai][0][m][1][e];
                    r0[e] = g0 * fast_sigmoid(g0) * acc[ai][1][m][0][e]; r1[e] = g1 * fast_sigmoid(g1) * acc[ai][1][m][1][e]; }
                *(u32x4*)rowp = pack8(r0, r1); }
    }
};

template <class Epi, class Sched, bool ALIGN_EPI = false, bool SP2 = false, bool MIDHOOK = false>
__device__ __forceinline__ void gemm_phase(PG8_LAS unsigned char* lds, const Gemm g, const Sched& S, const Epi& E) {
    const int tid = threadIdx.x, wid = __builtin_amdgcn_readfirstlane(tid >> 6), lane = tid & 63, wr = wid >> 2, wc = wid & 3, fr = lane & 15, fq = lane >> 4;
    const int K = g.K, nt = K / BK;
    unsigned voffA[2], voffB[2];
#pragma unroll
    for (int i = 0; i < 2; ++i) { int R, C; stage_rc(tid * 16 + i * 8192, R, C); const int Rb = Epi::PERM ? ((R & ~31) + perm32(R & 31)) : R;
        voffA[i] = (unsigned)(R * K + C) * 2u; voffB[i] = (unsigned)(Rb * K + C) * 2u; }
    const size_t kstep = (size_t)(BK * 2);
    const size_t hstep = (size_t)HALF * K * 2;
    const size_t tstep = 2 * hstep;
    const unsigned ldsw = (unsigned)wid * 1024u;
    const int aoff = lds_byte(wr * 64 + fr, fq * 8), boff = lds_byte(wc * 32 + fr, fq * 8);
#define PG8_SA(b, h) (((b) * 2 + (h)) * HTB)
#define PG8_SB(b, h) ((4 + (b) * 2 + (h)) * HTB)
#define PG8_STAGE(bufoff, gbase, voff) do { _Pragma("unroll") for (int _i = 0; _i < 2; ++_i) \
        __builtin_amdgcn_global_load_lds((const unsigned*)((const char*)(gbase) + (voff)[_i]), (PG8_LAS unsigned*)(lds + (bufoff) + ldsw + _i * 8192), 16, 0, 0); } while (0)
#define PG8_LDA(dst, b, h) do { _Pragma("unroll") for (int m = 0; m < 4; ++m) _Pragma("unroll") for (int k = 0; k < 2; ++k) dst[m][k] = *(const PG8_LAS bf16x8*)(lds + PG8_SA(b, h) + aoff + m * 2048 + k * 1024); } while (0)
#define PG8_LDB(dst, b, h) do { _Pragma("unroll") for (int n = 0; n < 2; ++n) _Pragma("unroll") for (int k = 0; k < 2; ++k) dst[n][k] = *(const PG8_LAS bf16x8*)(lds + PG8_SB(b, h) + boff + n * 2048 + k * 1024); } while (0)
#define PG8_MMA(ai, bj, At, Bt) do { __builtin_amdgcn_s_setprio(1); _Pragma("unroll") for (int m = 0; m < 4; ++m) _Pragma("unroll") for (int n = 0; n < 2; ++n) _Pragma("unroll") for (int k = 0; k < 2; ++k) \
        acc[ai][bj][m][n] = __builtin_amdgcn_mfma_f32_16x16x32_bf16(Bt[n][k], At[m][k], acc[ai][bj][m][n], 0, 0, 0); __builtin_amdgcn_s_setprio(0); } while (0)
#define PG8_WAIT_V(n) asm volatile("s_waitcnt vmcnt(" #n ")" ::: "memory")
#define PG8_WAIT_L(n) asm volatile("s_waitcnt lgkmcnt(" #n ")" ::: "memory")
#define PG8_BAR __builtin_amdgcn_s_barrier()
#define PG8_SCHED __builtin_amdgcn_sched_barrier(0)
    Unit cur, nxt; int ui = 0;
    if (!S.next(0, cur)) return;
    f32x4 acc[2][2][4][2];
#pragma unroll
    for (int a = 0; a < 2; ++a)
#pragma unroll
        for (int b = 0; b < 2; ++b)
#pragma unroll
            for (int m = 0; m < 4; ++m)
#pragma unroll
                for (int n = 0; n < 2; ++n) acc[a][b][m][n] = (f32x4){0.f, 0.f, 0.f, 0.f};
    bf16x8 At[4][2], B0[2][2], B1[2][2];
    const char* cA = (const char*)g.A + (size_t)cur.pm * tstep; const char* cB = (const char*)g.Bt + (size_t)cur.pn * tstep;
    S.a_ready(cur);
    if constexpr (SP2) {
        PG8_STAGE(PG8_SB(0, 0), cB, voffB); PG8_STAGE(PG8_SB(0, 1), cB + hstep, voffB); PG8_STAGE(PG8_SA(0, 0), cA, voffA); PG8_STAGE(PG8_SA(0, 1), cA + hstep, voffA);
        if (wr == 1) PG8_BAR;
        PG8_WAIT_V(2); PG8_BAR;
        PG8_STAGE(PG8_SB(1, 0), cB + kstep, voffB); PG8_STAGE(PG8_SA(1, 0), cA + kstep, voffA); PG8_STAGE(PG8_SB(1, 1), cB + hstep + kstep, voffB);
        PG8_WAIT_V(6); PG8_BAR;
    } else {
        PG8_STAGE(PG8_SB(0, 0), cB, voffB); PG8_STAGE(PG8_SA(0, 0), cA, voffA); PG8_STAGE(PG8_SB(0, 1), cB + hstep, voffB); PG8_STAGE(PG8_SA(0, 1), cA + hstep, voffA);
        if (wr == 1) PG8_BAR;
        PG8_WAIT_V(4); PG8_BAR;
        PG8_STAGE(PG8_SB(1, 0), cB + kstep, voffB); PG8_STAGE(PG8_SA(1, 0), cA + kstep, voffA); PG8_STAGE(PG8_SB(1, 1), cB + hstep + kstep, voffB);
        PG8_WAIT_V(6); PG8_BAR;
    }
    for (;;) {
        const bool has_next = S.next(ui + 1, nxt);
        const char* nA = has_next ? (const char*)g.A + (size_t)nxt.pm * tstep : cA; const char* nB = has_next ? (const char*)g.Bt + (size_t)nxt.pn * tstep : cB;
        for (int t = 0; t < nt; t += 2) {
            const bool last = (t == nt - 2);
            const char* a1 = cA + (size_t)(t + 1) * kstep;
            const char* a2 = last ? nA : cA + (size_t)(t + 2) * kstep; const char* b2 = last ? nB : cB + (size_t)(t + 2) * kstep;
            const char* a3 = a2 + kstep; const char* b3 = b2 + kstep;
            if (last && has_next) S.a_ready(nxt);
            if constexpr (SP2) {
            PG8_LDB(B0, 0, 0); PG8_LDB(B1, 0, 1); PG8_SCHED; PG8_LDA(At, 0, 0); PG8_STAGE(PG8_SA(1, 1), a1 + hstep, voffA);
            PG8_WAIT_V(8); PG8_WAIT_L(0); PG8_BAR; PG8_MMA(0, 0, At, B0); PG8_MMA(0, 1, At, B1); PG8_BAR; PG8_SCHED;
            PG8_LDA(At, 0, 1); PG8_STAGE(PG8_SB(0, 0), b2, voffB); PG8_STAGE(PG8_SB(0, 1), b2 + hstep, voffB); PG8_STAGE(PG8_SA(0, 0), a2, voffA);
            PG8_WAIT_V(8); PG8_WAIT_L(0); PG8_BAR; PG8_MMA(1, 0, At, B0); PG8_MMA(1, 1, At, B1); PG8_BAR; PG8_SCHED;
            PG8_LDB(B0, 1, 0); PG8_LDB(B1, 1, 1); PG8_SCHED; PG8_LDA(At, 1, 0); PG8_STAGE(PG8_SA(0, 1), a2 + hstep, voffA);
            PG8_WAIT_V(8); PG8_WAIT_L(0); PG8_BAR; PG8_MMA(0, 0, At, B0); PG8_MMA(0, 1, At, B1); PG8_BAR; PG8_SCHED;
            PG8_LDA(At, 1, 1); PG8_STAGE(PG8_SB(1, 0), b3, voffB); PG8_STAGE(PG8_SB(1, 1), b3 + hstep, voffB); PG8_STAGE(PG8_SA(1, 0), a3, voffA);
            PG8_WAIT_V(8); PG8_WAIT_L(0); PG8_BAR; PG8_MMA(1, 0, At, B0); PG8_MMA(1, 1, At, B1); PG8_BAR; PG8_SCHED;
            } else {
            PG8_LDB(B0, 0, 0); PG8_SCHED; PG8_LDA(At, 0, 0); PG8_STAGE(PG8_SA(1, 1), a1 + hstep, voffA);
            PG8_WAIT_L(8); PG8_BAR; PG8_WAIT_L(0); PG8_MMA(0, 0, At, B0); PG8_BAR; PG8_SCHED;
            PG8_LDB(B1, 0, 1); PG8_STAGE(PG8_SB(0, 0), b2, voffB);
            PG8_BAR; PG8_WAIT_L(0); PG8_MMA(0, 1, At, B1); PG8_BAR;
            PG8_LDA(At, 0, 1); PG8_STAGE(PG8_SA(0, 0), a2, voffA);
            PG8_BAR; PG8_WAIT_L(0); PG8_MMA(1, 0, At, B0); PG8_BAR; PG8_SCHED;
            PG8_STAGE(PG8_SB(0, 1), b2 + hstep, voffB);
            PG8_WAIT_V(6); PG8_BAR; PG8_MMA(1, 1, At, B1); PG8_BAR;
            PG8_LDB(B0, 1, 0); PG8_SCHED; PG8_LDA(At, 1, 0); PG8_STAGE(PG8_SA(0, 1), a2 + hstep, voffA);
            PG8_WAIT_L(8); PG8_BAR; PG8_WAIT_L(0); PG8_MMA(0, 0, At, B0); PG8_BAR; PG8_SCHED;
            PG8_LDB(B1, 1, 1); PG8_STAGE(PG8_SB(1, 0), b3, voffB);
            PG8_BAR; PG8_WAIT_L(0); PG8_MMA(0, 1, At, B1); PG8_BAR;
            PG8_LDA(At, 1, 1); PG8_STAGE(PG8_SA(1, 0), a3, voffA);
            PG8_BAR; PG8_WAIT_L(0); PG8_MMA(1, 0, At, B0); PG8_BAR; PG8_SCHED;
            PG8_STAGE(PG8_SB(1, 1), b3 + hstep, voffB);
            PG8_WAIT_V(6); PG8_BAR; PG8_MMA(1, 1, At, B1); PG8_BAR;
            }
            if constexpr (MIDHOOK) { if (t + 2 == Epi::mid_tiles) { E.mid(acc, cur, wr, wc, fr, fq); PG8_SCHED; } }
        }
        if constexpr (ALIGN_EPI) { if (wr == 0) PG8_BAR; }
        if constexpr (!Epi::AFTER_DRAIN) { E(acc, cur, wr, wc, fr, fq); S.done(cur); }
        if (!has_next) break;
#pragma unroll
        for (int a = 0; a < 2; ++a)
#pragma unroll
            for (int b = 0; b < 2; ++b)
#pragma unroll
                for (int m = 0; m < 4; ++m)
#pragma unroll
                    for (int n = 0; n < 2; ++n) acc[a][b][m][n] = (f32x4){0.f, 0.f, 0.f, 0.f};
        cur = nxt; cA = nA; cB = nB; ++ui;
        if constexpr (ALIGN_EPI) { if (wr == 1) PG8_BAR; }
    }
    PG8_WAIT_V(0);
    if constexpr (!ALIGN_EPI) { if (wr == 0) PG8_BAR; }
    PG8_BAR;
    if constexpr (Epi::AFTER_DRAIN) { E.fused(acc, cur, wr, wc, fr, fq, lds, wid, lane); S.done(cur); }
#undef PG8_SA
#undef PG8_SB
#undef PG8_STAGE
#undef PG8_LDA
#undef PG8_LDB
#undef PG8_MMA
#undef PG8_WAIT_V
#undef PG8_WAIT_L
#undef PG8_BAR
#undef PG8_SCHED
}
}

namespace att {
typedef unsigned short bf16_t;
typedef short bf16x8 __attribute__((ext_vector_type(8)));
typedef short s16x4 __attribute__((ext_vector_type(4)));
typedef float f32x16 __attribute__((ext_vector_type(16)));
typedef float f32x4 __attribute__((ext_vector_type(4)));
typedef unsigned u32x4 __attribute__((ext_vector_type(4)));
typedef unsigned u32x2 __attribute__((ext_vector_type(2)));
#define ALAS __attribute__((address_space(3)))
constexpr int SEQ = 4096, PITCH = 3072, SLOTB = 8192;
constexpr int NSLOT = 3, L_K = 0, L_V = NSLOT * SLOTB, L_CK = 2 * NSLOT * SLOTB, L_FLAG = L_CK + 16384, L_KMAX = L_FLAG + 64, L_RED = L_KMAX + 64, L_END = L_RED + 64;
constexpr float LOG2E = 1.4426950408889634f;
constexpr float FX_DONE = -152.f;
constexpr float SB_DONE = -160.f;
__device__ __forceinline__ int crow(int r, int hi) { return (r & 3) + 8 * (r >> 2) + 4 * hi; }
__device__ __forceinline__ void glds16(const void* gsrc, unsigned lds_dst) { unsigned keep;
    asm volatile("s_mov_b32 %0, m0\n\ts_mov_b32 m0, %2\n\ts_nop 0\n\tglobal_load_lds_dwordx4 %1, off\n\ts_mov_b32 m0, %0" : "=&s"(keep) : "v"(gsrc), "s"(lds_dst) : "memory"); }
typedef float f32x2_t __attribute__((ext_vector_type(2))); typedef __bf16 bf16x2_t __attribute__((ext_vector_type(2)));
__device__ __forceinline__ unsigned cvtpk(float lo, float hi) { f32x2_t v = {lo, hi}; bf16x2_t b = __builtin_convertvector(v, bf16x2_t); return __builtin_bit_cast(unsigned, b); }
typedef short v4i16_t __attribute__((ext_vector_type(4)));
__device__ __forceinline__ s16x4 vtr(const ALAS unsigned char* p) { return __builtin_bit_cast(s16x4, __builtin_amdgcn_ds_read_tr16_b64_v4i16((ALAS v4i16_t*)p)); }
#define ATT_WAIT_BAR(N) asm volatile("s_waitcnt vmcnt(" #N ") lgkmcnt(0)\n\ts_barrier" ::: "memory")
#define ATT_BAR() asm volatile("s_waitcnt lgkmcnt(0)\n\ts_barrier" ::: "memory")


__device__ __forceinline__ void fox_kmax(int b, int h, const bf16_t* K, ALAS unsigned char* shm) {
    const int tid = threadIdx.x, lane = tid & 63, wid = __builtin_amdgcn_readfirstlane(tid >> 6);
    float mx = 0.f;
    for (int r = tid; r < SEQ; r += 512) {
        const bf16_t* kr = K + ((long)b * SEQ + r) * PITCH + h * 64;
        float s = 0.f;
#pragma unroll
        for (int c = 0; c < 8; ++c) { const u32x4 w = *(const u32x4*)(kr + 8 * c);
#pragma unroll
            for (int e = 0; e < 4; ++e) { const float lo = __uint_as_float(w[e] << 16), hi = __uint_as_float(w[e] & 0xffff0000u); s += lo * lo + hi * hi; } }
        mx = fmaxf(mx, s);
    }
#pragma unroll
    for (int o = 1; o < 64; o <<= 1) mx = fmaxf(mx, __shfl_xor(mx, o));
    ALAS float* red = (ALAS float*)(shm + L_RED);
    if (lane == 0) red[wid] = mx;
    __syncthreads();
    if (tid == 0) { float m = red[0];
#pragma unroll
        for (int w = 1; w < 8; ++w) m = fmaxf(m, red[w]);
        *(ALAS float*)(shm + L_KMAX) = sqrtf(m); }
    __syncthreads();
}

template <bool SB>
__device__ __forceinline__ void attn_unit(int b, int h, int qb, const bf16_t* Q, const bf16_t* K, const bf16_t* V, const float* cum, bf16_t* O, ALAS unsigned char* shm) {
    const int tid = threadIdx.x, lane = tid & 63, r32 = lane & 31, hi = lane >> 5;
    const int wid = __builtin_amdgcn_readfirstlane(tid >> 6);
    const long rowbase = (long)b * SEQ; const int q0 = qb * 256;
    const int wq0 = q0 + wid * 32, qrow = wq0 + r32;
    const unsigned lds0 = (unsigned)(uintptr_t)shm;
    ALAS float* ck = (ALAS float*)(shm + L_CK);
    ALAS unsigned* flag = (ALAS unsigned*)(shm + L_FLAG);
    const int NT = (q0 + 256) / 64;
    const bf16_t* ksrc = K + (rowbase + lane) * PITCH + h * 64 + wid * 8;
    const bf16_t* vsrc = V + (rowbase + 16 * (wid & 3) + (lane >> 2)) * PITCH + h * 64 + (wid >> 2) * 32 + (lane & 3) * 8;
    const unsigned kdst = lds0 + L_K + wid * 1024, vdst = lds0 + L_V + wid * 1024;
#define ATT_DMA(t, so) do { glds16(ksrc + (long)(t) * 64 * PITCH, (unsigned)__builtin_amdgcn_readfirstlane(kdst + (so))); glds16(vsrc + (long)(t) * 64 * PITCH, (unsigned)__builtin_amdgcn_readfirstlane(vdst + (so))); } while (0)
    ATT_DMA(NT - 1, 0); ATT_DMA(NT - 2, SLOTB);
    bf16x8 qr[4];
    { const bf16_t* Qw = Q + (rowbase + qrow) * PITCH + h * 64 + hi * 8;
#pragma unroll
      for (int d0 = 0; d0 < 4; ++d0) qr[d0] = *(const bf16x8*)(Qw + d0 * 16); }
    float cq2 = 0.f, qkb = 0.f;
    if (!SB) {
        for (int i = tid; i < q0 + 256; i += 512) ck[i] = cum[i] * LOG2E;
        cq2 = cum[qrow] * LOG2E;
        float s = 0.f;
#pragma unroll
        for (int d0 = 0; d0 < 4; ++d0) { const u32x4 w = __builtin_bit_cast(u32x4, qr[d0]);
#pragma unroll
            for (int e = 0; e < 4; ++e) { const float lo = __uint_as_float(w[e] << 16), hh = __uint_as_float(w[e] & 0xffff0000u); s += lo * lo + hh * hh; } }
        { auto rr = __builtin_amdgcn_permlane32_swap(__float_as_uint(s), __float_as_uint(s), false, false); s = __uint_as_float(rr[0]) + __uint_as_float(rr[1]); }
        qkb = sqrtf(s) * (*(const ALAS float*)(shm + L_KMAX)) * 1.01f + 0.5f;
    }
    f32x16 o0 = {}, o1 = {};
    float mref = 0.f, l_run = 0.f, carry = SB ? 1.f : 0.f;
    bool started = false, wdone = false;
    const ALAS unsigned char* kp0 = shm + L_K + hi * 1024 + r32 * 16;
    const ALAS unsigned char* vp0 = shm + L_V + ((lane >> 4) & 1) * 32 + (lane & 3) * 8 + (4 * hi + ((lane & 15) >> 2)) * 64;
    int so = 0;
    for (int t = NT - 1; t >= 0; --t) {
        if (t > 0) { ATT_WAIT_BAR(2); } else { ATT_WAIT_BAR(0); }
        if (t < NT - 1) {
            const ALAS unsigned* fp = flag + ((t + 1) & 1) * 8;
            const u32x4 f0 = *(const ALAS u32x4*)fp, f1 = *(const ALAS u32x4*)(fp + 4);
            const unsigned all = f0.x & f0.y & f0.z & f0.w & f1.x & f1.y & f1.z & f1.w;
            if (__builtin_amdgcn_readfirstlane(all) != 0u) break;
        }
        if (t >= 2) { const int sn = (so == 0) ? 2 * SLOTB : so - SLOTB; ATT_DMA(t - 2, sn); }
        const int kv0 = 64 * t;
        if (kv0 <= wq0 + 31 && !wdone) {
            const bool needmask = (kv0 + 63 >= wq0);
            const ALAS unsigned char* kp = kp0 + so;
            f32x16 p0, p1;
            if (!SB) {
                const float base = cq2 - mref;
                const ALAS float* ckp = ck + kv0 + 4 * hi;
#pragma unroll
                for (int g = 0; g < 4; ++g) { const f32x4 c0 = *(const ALAS f32x4*)(ckp + 8 * g), c1 = *(const ALAS f32x4*)(ckp + 32 + 8 * g);
#pragma unroll
                    for (int e = 0; e < 4; ++e) { p0[4 * g + e] = base - c0[e]; p1[4 * g + e] = base - c1[e]; } }
            } else { p0 = f32x16{}; p1 = f32x16{}; }
#pragma unroll
            for (int d0 = 0; d0 < 4; ++d0) {
                const bf16x8 b0 = *(const ALAS bf16x8*)(kp + d0 * 2048), b1 = *(const ALAS bf16x8*)(kp + d0 * 2048 + 512);
                p0 = __builtin_amdgcn_mfma_f32_32x32x16_bf16(b0, qr[d0], p0, 0, 0, 0);
                p1 = __builtin_amdgcn_mfma_f32_32x32x16_bf16(b1, qr[d0], p1, 0, 0, 0);
            }
            if (!SB) {
                if (needmask) {
#pragma unroll
                    for (int r = 0; r < 16; ++r) { const int kv = kv0 + crow(r, hi); if (kv > qrow) p0[r] = -INFINITY; if (kv + 32 > qrow) p1[r] = -INFINITY; }
                }
                float mx = fmaxf(fmaxf(p0[0], p1[0]), fmaxf(p0[1], p1[1]));
#pragma unroll
                for (int r = 2; r < 16; r += 2) mx = fmaxf(fmaxf(mx, p0[r]), fmaxf(p1[r], fmaxf(p0[r + 1], p1[r + 1])));
                { auto rr = __builtin_amdgcn_permlane32_swap(__float_as_uint(mx), __float_as_uint(mx), false, false); mx = fmaxf(__uint_as_float(rr[0]), __uint_as_float(rr[1])); }
                if (__any(mx > 0.f) || !started) {
                    const float dl = started ? fmaxf(mx, 0.f) : mx;
                    mref += dl;
                    const float alpha = started ? __builtin_amdgcn_exp2f(-dl) : 0.f;
                    l_run *= alpha;
#pragma unroll
                    for (int r = 0; r < 16; ++r) { p0[r] -= dl; p1[r] -= dl; o0[r] *= alpha; o1[r] *= alpha; }
                    started = true;
                }
                float s0 = 0.f, s1 = 0.f;
#pragma unroll
                for (int r = 0; r < 16; ++r) { p0[r] = __builtin_amdgcn_exp2f(p0[r]); p1[r] = __builtin_amdgcn_exp2f(p1[r]); s0 += p0[r]; s1 += p1[r]; }
                l_run += s0 + s1;
                wdone = __all(qkb + cq2 - ck[kv0] - mref < FX_DONE);
            } else {
                f32x16 K0, K1;
#pragma unroll
                for (int r = 0; r < 16; ++r) {
                    const float e0 = __builtin_amdgcn_exp2f(fminf(p0[r], 120.f)), e1 = __builtin_amdgcn_exp2f(fminf(p1[r], 120.f));
                    float k0 = __builtin_amdgcn_rcpf(1.f + e0), k1 = __builtin_amdgcn_rcpf(1.f + e1);
                    float b0 = e0 * k0, b1 = e1 * k1;
                    if (needmask) { const int kv = kv0 + crow(r, hi); if (kv >= qrow) { k0 = 1.f; b0 = 0.f; } if (kv + 32 >= qrow) { k1 = 1.f; b1 = 0.f; } }
                    K0[r] = k0; K1[r] = k1; p0[r] = b0; p1[r] = b1;
                }
                float lo[8], hv[8];
#pragma unroll
                for (int g = 0; g < 4; ++g) {
                    const float g0 = (K0[4 * g] * K0[4 * g + 1]) * (K0[4 * g + 2] * K0[4 * g + 3]);
                    const float g1 = (K1[4 * g] * K1[4 * g + 1]) * (K1[4 * g + 2] * K1[4 * g + 3]);
                    auto r0 = __builtin_amdgcn_permlane32_swap(__float_as_uint(g0), __float_as_uint(g0), false, false);
                    auto r1 = __builtin_amdgcn_permlane32_swap(__float_as_uint(g1), __float_as_uint(g1), false, false);
                    lo[g] = __uint_as_float(r0[0]); hv[g] = __uint_as_float(r0[1]); lo[4 + g] = __uint_as_float(r1[0]); hv[4 + g] = __uint_as_float(r1[1]);
                }
                float E[8]; float R = carry;
#pragma unroll
                for (int i = 7; i >= 0; --i) { const float eh = R; R *= hv[i]; const float el = R; R *= lo[i]; E[i] = hi ? eh : el; }
                carry = R;
#pragma unroll
                for (int g = 0; g < 4; ++g) {
                    float run0 = E[g], run1 = E[4 + g];
#pragma unroll
                    for (int e = 3; e >= 0; --e) { const int r = 4 * g + e;
                        p0[r] *= run0; p1[r] *= run1; run0 *= K0[r]; run1 *= K1[r]; }
                }
                wdone = __all(carry == 0.f);
            }
            u32x4 w;
            bf16x8 pa[4];
            w = (u32x4){cvtpk(p0[0], p0[1]), cvtpk(p0[2], p0[3]), cvtpk(p0[4], p0[5]), cvtpk(p0[6], p0[7])}; pa[0] = __builtin_bit_cast(bf16x8, w);
            w = (u32x4){cvtpk(p0[8], p0[9]), cvtpk(p0[10], p0[11]), cvtpk(p0[12], p0[13]), cvtpk(p0[14], p0[15])}; pa[1] = __builtin_bit_cast(bf16x8, w);
            w = (u32x4){cvtpk(p1[0], p1[1]), cvtpk(p1[2], p1[3]), cvtpk(p1[4], p1[5]), cvtpk(p1[6], p1[7])}; pa[2] = __builtin_bit_cast(bf16x8, w);
            w = (u32x4){cvtpk(p1[8], p1[9]), cvtpk(p1[10], p1[11]), cvtpk(p1[12], p1[13]), cvtpk(p1[14], p1[15])}; pa[3] = __builtin_bit_cast(bf16x8, w);
            const ALAS unsigned char* vp = vp0 + so;
#pragma unroll
            for (int s = 0; s < 4; ++s) {
                const s16x4 a0 = vtr(vp + s * 1024), a1 = vtr(vp + s * 1024 + 512), c0 = vtr(vp + 4096 + s * 1024), c1 = vtr(vp + 4096 + s * 1024 + 512);
                const bf16x8 v0 = {a0[0], a0[1], a0[2], a0[3], a1[0], a1[1], a1[2], a1[3]}, v1 = {c0[0], c0[1], c0[2], c0[3], c1[0], c1[1], c1[2], c1[3]};
                o0 = __builtin_amdgcn_mfma_f32_32x32x16_bf16(v0, pa[s], o0, 0, 0, 0);
                o1 = __builtin_amdgcn_mfma_f32_32x32x16_bf16(v1, pa[s], o1, 0, 0, 0);
            }
        }
        if (lane == 0) flag[(t & 1) * 8 + wid] = wdone ? 1u : 0u;
        so = (so == 2 * SLOTB) ? 0 : so + SLOTB;
    }
    asm volatile("s_waitcnt vmcnt(0) lgkmcnt(0)\n\ts_barrier" ::: "memory");
    float inv = 1.f;
    if (!SB) { auto rr = __builtin_amdgcn_permlane32_swap(__float_as_uint(l_run), __float_as_uint(l_run), false, false); inv = 1.f / (__uint_as_float(rr[0]) + __uint_as_float(rr[1])); }
    bf16_t* Ow = O + (rowbase + qrow) * 512 + h * 64 + 4 * hi;
#pragma unroll
    for (int g = 0; g < 4; ++g) {
        u32x2 w0, w1;
        w0.x = cvtpk(o0[4 * g] * inv, o0[4 * g + 1] * inv); w0.y = cvtpk(o0[4 * g + 2] * inv, o0[4 * g + 3] * inv);
        w1.x = cvtpk(o1[4 * g] * inv, o1[4 * g + 1] * inv); w1.y = cvtpk(o1[4 * g + 2] * inv, o1[4 * g + 3] * inv);
        *(u32x2*)(Ow + 8 * g) = w0; *(u32x2*)(Ow + 32 + 8 * g) = w1;
    }
#undef ATT_DMA
}

__device__ __forceinline__ void sb_wave_block(int b, int h, int j, const bf16_t* Q, const bf16_t* K, const bf16_t* V, bf16_t* O, ALAS unsigned char* wl) {
    const int lane = threadIdx.x & 63, r32 = lane & 31, hi = lane >> 5;
    const long rowbase = (long)b * SEQ; const int qrow = 32 * j + r32;
    const unsigned l0 = (unsigned)(uintptr_t)wl;
    const bf16_t* ksrc = K + (rowbase + (lane & 31)) * PITCH + h * 64 + (lane >> 5) * 8;
    const bf16_t* vsrc = V + (rowbase + (lane >> 2)) * PITCH + h * 64 + (lane & 3) * 8;
#define SBW_DMA(tt, bo) do { const long ro_ = (long)(tt) * 32 * PITCH; \
        _Pragma("unroll") for (int c_ = 0; c_ < 4; ++c_) glds16(ksrc + ro_ + c_ * 16, (unsigned)__builtin_amdgcn_readfirstlane(l0 + (bo) + c_ * 1024)); \
        _Pragma("unroll") for (int p_ = 0; p_ < 4; ++p_) glds16(vsrc + ro_ + (long)(16 * (p_ & 1)) * PITCH + (p_ >> 1) * 32, (unsigned)__builtin_amdgcn_readfirstlane(l0 + (bo) + 4096 + p_ * 1024)); } while (0)
    SBW_DMA(j, 0);
    bf16x8 qr[4];
    { const bf16_t* Qw = Q + (rowbase + qrow) * PITCH + h * 64 + hi * 8;
#pragma unroll
      for (int d0 = 0; d0 < 4; ++d0) qr[d0] = *(const bf16x8*)(Qw + d0 * 16); }
    f32x16 o0 = {}, o1 = {};
    float carry = 1.f;
    const ALAS unsigned char* kp0 = wl + hi * 512 + r32 * 16;
    const ALAS unsigned char* vp0 = wl + 4096 + ((lane >> 4) & 1) * 32 + (lane & 3) * 8 + (4 * hi + ((lane & 15) >> 2)) * 64;
    int bo = 0;
    for (int tt = j; tt >= 0; --tt) {
        asm volatile("s_waitcnt lgkmcnt(0)" ::: "memory");
        if (tt > 0) { SBW_DMA(tt - 1, bo ^ 8192); asm volatile("s_waitcnt vmcnt(8)" ::: "memory"); } else { asm volatile("s_waitcnt vmcnt(0)" ::: "memory"); }
        const int kv0 = 32 * tt;
        const ALAS unsigned char* kp = kp0 + bo;
        f32x16 p0 = {};
#pragma unroll
        for (int d0 = 0; d0 < 4; ++d0) { const bf16x8 kf = *(const ALAS bf16x8*)(kp + d0 * 1024); p0 = __builtin_amdgcn_mfma_f32_32x32x16_bf16(kf, qr[d0], p0, 0, 0, 0); }
        const bool diag = (tt == j);
        f32x16 K0;
#pragma unroll
        for (int r = 0; r < 16; ++r) {
            const float e0 = __builtin_amdgcn_exp2f(fminf(p0[r], 120.f));
            float k0 = __builtin_amdgcn_rcpf(1.f + e0), b0 = e0 * k0;
            if (diag) { const int kv = kv0 + crow(r, hi); if (kv >= qrow) { k0 = 1.f; b0 = 0.f; } }
            K0[r] = k0; p0[r] = b0;
        }
        float lo[4], hv[4];
#pragma unroll
        for (int g = 0; g < 4; ++g) { const float g0 = (K0[4 * g] * K0[4 * g + 1]) * (K0[4 * g + 2] * K0[4 * g + 3]);
            auto r0 = __builtin_amdgcn_permlane32_swap(__float_as_uint(g0), __float_as_uint(g0), false, false);
            lo[g] = __uint_as_float(r0[0]); hv[g] = __uint_as_float(r0[1]); }
        float E[4]; float R = carry;
#pragma unroll
        for (int i = 3; i >= 0; --i) { const float eh = R; R *= hv[i]; const float el = R; R *= lo[i]; E[i] = hi ? eh : el; }
        carry = R;
#pragma unroll
        for (int g = 0; g < 4; ++g) { float run0 = E[g];
#pragma unroll
            for (int e = 3; e >= 0; --e) { const int r = 4 * g + e; p0[r] *= run0; run0 *= K0[r]; } }
        u32x4 w; bf16x8 pa[2];
        w = (u32x4){cvtpk(p0[0], p0[1]), cvtpk(p0[2], p0[3]), cvtpk(p0[4], p0[5]), cvtpk(p0[6], p0[7])}; pa[0] = __builtin_bit_cast(bf16x8, w);
        w = (u32x4){cvtpk(p0[8], p0[9]), cvtpk(p0[10], p0[11]), cvtpk(p0[12], p0[13]), cvtpk(p0[14], p0[15])}; pa[1] = __builtin_bit_cast(bf16x8, w);
        const ALAS unsigned char* vp = vp0 + bo;
#pragma unroll
        for (int s = 0; s < 2; ++s) {
            const s16x4 a0 = vtr(vp + s * 1024), a1 = vtr(vp + s * 1024 + 512), c0 = vtr(vp + 2048 + s * 1024), c1 = vtr(vp + 2048 + s * 1024 + 512);
            const bf16x8 v0 = {a0[0], a0[1], a0[2], a0[3], a1[0], a1[1], a1[2], a1[3]}, v1 = {c0[0], c0[1], c0[2], c0[3], c1[0], c1[1], c1[2], c1[3]};
            o0 = __builtin_amdgcn_mfma_f32_32x32x16_bf16(v0, pa[s], o0, 0, 0, 0);
            o1 = __builtin_amdgcn_mfma_f32_32x32x16_bf16(v1, pa[s], o1, 0, 0, 0);
        }
        bo ^= 8192;
        if (__all(carry == 0.f)) break;
    }
    asm volatile("s_waitcnt vmcnt(0) lgkmcnt(0)" ::: "memory");
    bf16_t* Ow = O + (rowbase + qrow) * 512 + h * 64 + 4 * hi;
#pragma unroll
    for (int g = 0; g < 4; ++g) {
        u32x2 w0, w1;
        w0.x = cvtpk(o0[4 * g], o0[4 * g + 1]); w0.y = cvtpk(o0[4 * g + 2], o0[4 * g + 3]);
        w1.x = cvtpk(o1[4 * g], o1[4 * g + 1]); w1.y = cvtpk(o1[4 * g + 2], o1[4 * g + 3]);
        *(u32x2*)(Ow + 8 * g) = w0; *(u32x2*)(Ow + 32 + 8 * g) = w1;
    }
#undef SBW_DMA
}
}


#define LAS __attribute__((address_space(3)))
typedef unsigned short bf16;
typedef float f32x4 __attribute__((ext_vector_type(4)));
typedef unsigned u32x4v __attribute__((ext_vector_type(4)));
typedef unsigned u32x2v __attribute__((ext_vector_type(2)));
constexpr int NB = 16, SEQ = 4096, DM = 1024, T = NB * SEQ, DFF = 2816, DINP = 5128, NIN = 5120, NMOD = 6144;
constexpr float RMS_EPS = 1e-6f;
constexpr float QSCALE = 0.125f * 1.4426950408889634f;
constexpr size_t MiB = 1u << 20;
constexpr size_t WS_MOD = 1 * MiB, WS_LOGF = 2 * MiB, WS_CUM = 4 * MiB, WS_WIN = 8 * MiB, WS_WSB = 18 * MiB, WS_WFX = 19 * MiB, WS_WOUT = 20 * MiB, WS_WGU = 22 * MiB, WS_WDN = 34 * MiB;
constexpr size_t WS_H = 64 * MiB, WS_YSB = 192 * MiB, WS_YFX = 256 * MiB, WS_GATES = 320 * MiB, WS_QKV = 576 * MiB, WS_ACT = 576 * MiB, WS_END = 960 * MiB;
constexpr int LDS_BYTES = 147456;
constexpr int NPHASE = 11;

struct Args { const float* in[16]; float* out; unsigned char* ws; int ph_lo, ph_hi; };

__device__ __forceinline__ float wave_sum(float v) {
#pragma unroll
    for (int o = 1; o < 64; o <<= 1) v += __shfl_xor(v, o);
    return v;
}
__device__ __forceinline__ unsigned f2bf(float f) { unsigned u = __builtin_bit_cast(unsigned, f); return (u + 0x7fffu + ((u >> 16) & 1u)) >> 16; }
__device__ __forceinline__ unsigned pk2(float lo, float hi) { return f2bf(lo) | (f2bf(hi) << 16); }

__device__ __forceinline__ void transpose_item(const float* W, int ldw, int K, int src_col0, bf16* WT, int dst_row0, int k0, LAS float* scr, int lane) {
#pragma unroll 8
    for (int i = 0; i < 32; ++i) { const int kk = 2 * i + (lane >> 5); scr[kk * 33 + (lane & 31)] = W[(size_t)(k0 + kk) * ldw + src_col0 + (lane & 31)]; }
    asm volatile("s_waitcnt lgkmcnt(0)" ::: "memory");
    const int c = lane & 7;
#pragma unroll
    for (int j = 0; j < 4; ++j) { const int n = (lane >> 3) + 8 * j; const LAS float* s = scr + (8 * c) * 33 + n;
        u32x4v o; o.x = pk2(s[0 * 33], s[1 * 33]); o.y = pk2(s[2 * 33], s[3 * 33]); o.z = pk2(s[4 * 33], s[5 * 33]); o.w = pk2(s[6 * 33], s[7 * 33]);
        *(u32x4v*)(WT + (size_t)(dst_row0 + n) * K + k0 + 8 * c) = o; }
    asm volatile("s_waitcnt lgkmcnt(0)" ::: "memory");
}

__device__ __forceinline__ void phase_prologue(const Args& a, LAS unsigned char* lds, int tid, int lane, int wave, int G) {
    unsigned char* ws = a.ws;
    float* mod = (float*)(ws + WS_MOD);
    for (int item = blockIdx.x; item < NMOD / 64; item += G) {
        LAS float* sc = (LAS float*)lds;
        LAS float* red = (LAS float*)(lds + 65536);
        const float* c = a.in[1];
        for (int i = tid; i < NB * DM; i += 512) { const int b = i >> 10, k = i & 1023; const float v = c[i]; sc[k * 16 + b] = v / (1.f + __expf(-v)); }
        __syncthreads();
        const float* w = a.in[2] + item * 64 + lane;
        float acc[16];
#pragma unroll
        for (int b = 0; b < 16; ++b) acc[b] = 0.f;
        const int k0 = wave * 128;
#pragma unroll 4
        for (int k = k0; k < k0 + 128; ++k) {
            const float wv = w[(size_t)k * NMOD];
            const LAS f32x4* s4 = (const LAS f32x4*)(sc + k * 16);
#pragma unroll
            for (int q = 0; q < 4; ++q) { const f32x4 s = s4[q]; acc[4 * q] += s.x * wv; acc[4 * q + 1] += s.y * wv; acc[4 * q + 2] += s.z * wv; acc[4 * q + 3] += s.w * wv; }
        }
#pragma unroll
        for (int b = 0; b < 16; ++b) red[(wave * 16 + b) * 64 + lane] = acc[b];
        __syncthreads();
        for (int o = tid; o < 1024; o += 512) { const int b = o >> 6, l = o & 63; float s = 0.f;
#pragma unroll
            for (int w8 = 0; w8 < 8; ++w8) s += red[(w8 * 16 + b) * 64 + l];
            mod[b * NMOD + item * 64 + l] = s + a.in[3][item * 64 + l]; }
        __syncthreads();
    }
    LAS float* scr = (LAS float*)(lds + wave * 16384);
    const int gw = blockIdx.x * 8 + wave, NGW = G * 8;
    bf16* WIN = (bf16*)(ws + WS_WIN); bf16* WSB = (bf16*)(ws + WS_WSB); bf16* WFX = (bf16*)(ws + WS_WFX); bf16* WOUT = (bf16*)(ws + WS_WOUT); bf16* WGU = (bf16*)(ws + WS_WGU); bf16* WDN = (bf16*)(ws + WS_WDN);
    constexpr int I0 = 16 * 96, I1 = 16 * 64, I2 = 8 * 32, I3 = 8 * 32, I4 = 16 * 32, I5 = 16 * 88, I6 = 16 * 88, I7 = 44 * 32;
    constexpr int NITEMS = I0 + I1 + I2 + I3 + I4 + I5 + I6 + I7;
    for (int it = gw; it < NITEMS; it += NGW) {
        int r = it;
        if (r < I0) { const int kb = r / 96, nb = r % 96; transpose_item(a.in[5], DINP, 1024, 32 * nb, WIN, 32 * nb, 64 * kb, scr, lane); continue; } r -= I0;
        if (r < I1) { const int kb = r / 64, nb = r % 64; transpose_item(a.in[5], DINP, 1024, 3080 + 32 * nb, WIN, 3072 + 32 * nb, 64 * kb, scr, lane); continue; } r -= I1;
        if (r < I2) { const int kb = r / 32, nb = r % 32; transpose_item(a.in[8], 1024, 512, 32 * nb, WSB, 32 * nb, 64 * kb, scr, lane); continue; } r -= I2;
        if (r < I3) { const int kb = r / 32, nb = r % 32; transpose_item(a.in[9], 1024, 512, 32 * nb, WFX, 32 * nb, 64 * kb, scr, lane); continue; } r -= I3;
        if (r < I4) { const int kb = r / 32, nb = r % 32; transpose_item(a.in[10], 1024, 1024, 32 * nb, WOUT, 32 * nb, 64 * kb, scr, lane); continue; } r -= I4;
        if (r < I5) { const int kb = r / 88, nb = r % 88, n0 = 32 * nb; transpose_item(a.in[12], DFF, 1024, n0, WGU, (n0 >> 7) * 256 + (n0 & 127), 64 * kb, scr, lane); continue; } r -= I5;
        if (r < I6) { const int kb = r / 88, nb = r % 88, n0 = 32 * nb; transpose_item(a.in[13], DFF, 1024, n0, WGU, (n0 >> 7) * 256 + 128 + (n0 & 127), 64 * kb, scr, lane); continue; } r -= I6;
        { const int kb = r / 32, nb = r % 32; transpose_item(a.in[14], 1024, DFF, 32 * nb, WDN, 32 * nb, 64 * kb, scr, lane); }
    }
}

template <int MODE>
__device__ __forceinline__ void norm_pass(const Args& a, LAS unsigned char* lds, int tid, int lane, int wave, int G) {
    unsigned char* ws = a.ws;
    const float* mod = (const float*)(ws + WS_MOD);
    const float* src = a.in[0];
    const bf16* srcb = MODE == 1 ? (const bf16*)(ws + WS_YSB) : (const bf16*)(ws + WS_H);
    const float* gvec = MODE == 0 ? a.in[4] : (MODE == 1 ? a.in[11] : a.in[15]);
    constexpr int SH = MODE == 0 ? 0 : 3 * DM, SC = MODE == 0 ? DM : 4 * DM;
    bf16* H = (bf16*)(ws + WS_H);
    float* LOGF = (float*)(ws + WS_LOGF);
    LAS float* wfL = (LAS float*)lds;
    if (MODE == 0) {
        for (int i = tid; i < 8192; i += 512) { const int jj = i >> 10, k = i & 1023; wfL[i] = a.in[5][(size_t)k * DINP + 3072 + jj]; }
        __syncthreads();
    }
    const int gw = blockIdx.x * 8 + wave, NGW = G * 8;
    for (int r0 = gw * 32; r0 < T; r0 += NGW * 32) {
        const int b = r0 >> 12;
        f32x4 gs[4], sh[4];
#pragma unroll
        for (int j = 0; j < 4; ++j) { const int col = 4 * lane + 256 * j; const f32x4 g4 = *(const f32x4*)(gvec + col);
            if (MODE < 2) { const f32x4 s4 = *(const f32x4*)(mod + b * NMOD + SC + col); sh[j] = *(const f32x4*)(mod + b * NMOD + SH + col); gs[j] = g4 * (1.f + s4); }
            else { gs[j] = g4; sh[j] = (f32x4){0.f, 0.f, 0.f, 0.f}; } }
        f32x4 vn[4];
#define NP_LOAD(dst, row_) do { if (MODE == 0) { const f32x4* xr_ = (const f32x4*)(src + (size_t)(row_) * DM) + lane; \
                _Pragma("unroll") for (int j = 0; j < 4; ++j) dst[j] = xr_[64 * j]; } \
            else { const u32x2v* xr_ = (const u32x2v*)(srcb + (size_t)(row_) * DM) + lane; \
                _Pragma("unroll") for (int j = 0; j < 4; ++j) { const u32x2v w_ = xr_[64 * j]; \
                    dst[j] = (f32x4){__uint_as_float(w_.x << 16), __uint_as_float(w_.x & 0xffff0000u), __uint_as_float(w_.y << 16), __uint_as_float(w_.y & 0xffff0000u)}; } } } while (0)
        NP_LOAD(vn, r0);
        for (int rr = 0; rr < 32; ++rr) {
            const size_t row = (size_t)r0 + rr;
            f32x4 v[4];
#pragma unroll
            for (int j = 0; j < 4; ++j) v[j] = vn[j];
            if (rr < 31) NP_LOAD(vn, row + 1);
            float ss = 0.f;
#pragma unroll
            for (int j = 0; j < 4; ++j) ss += (v[j].x * v[j].x + v[j].y * v[j].y) + (v[j].z * v[j].z + v[j].w * v[j].w);
            ss = wave_sum(ss);
            const float rstd = 1.0f / sqrtf(ss * (1.0f / DM) + RMS_EPS);
#pragma unroll
            for (int j = 0; j < 4; ++j) v[j] = v[j] * rstd * gs[j] + sh[j];
            if (MODE == 2) { f32x4* o = (f32x4*)(a.out + row * DM) + lane;
#pragma unroll
                for (int j = 0; j < 4; ++j) o[64 * j] = v[j]; }
            else { u32x2v* o = (u32x2v*)(H + row * DM) + lane;
#pragma unroll
                for (int j = 0; j < 4; ++j) { u32x2v w; w.x = pk2(v[j].x, v[j].y); w.y = pk2(v[j].z, v[j].w); o[64 * j] = w; } }
            if (MODE == 0) {
                float f[8];
#pragma unroll
                for (int jj = 0; jj < 8; ++jj) { float s = 0.f;
#pragma unroll
                    for (int j = 0; j < 4; ++j) { const f32x4 w4 = *(const LAS f32x4*)(wfL + jj * 1024 + 4 * lane + 256 * j); s += (v[j].x * w4.x + v[j].y * w4.y) + (v[j].z * w4.z + v[j].w * w4.w); }
                    f[jj] = s; }
                const bool h5 = (lane & 32) != 0, h4 = (lane & 16) != 0, h3 = (lane & 8) != 0;
#pragma unroll
                for (int i = 0; i < 4; ++i) { const float send = h5 ? f[i] : f[i + 4], keep = h5 ? f[i + 4] : f[i]; f[i] = keep + __shfl_xor(send, 32); }
#pragma unroll
                for (int i = 0; i < 2; ++i) { const float send = h4 ? f[i] : f[i + 2], keep = h4 ? f[i + 2] : f[i]; f[i] = keep + __shfl_xor(send, 16); }
                { const float send = h3 ? f[0] : f[1], keep = h3 ? f[1] : f[0]; f[0] = keep + __shfl_xor(send, 8); }
                f[0] += __shfl_xor(f[0], 4); f[0] += __shfl_xor(f[0], 2); f[0] += __shfl_xor(f[0], 1);
                if ((lane & 7) == 0) { const int jj = lane >> 3; const float val = f[0] + a.in[6][jj];
                    LOGF[((size_t)(b * 8 + jj) << 12) + (row & 4095)] = fminf(val, 0.f) - log1pf(__expf(-fabsf(val))); }
            }
        }
    }
}

__device__ __forceinline__ void scan_phase(const Args& a, LAS unsigned char* lds, int tid, int lane, int wave, int G) {
    const float* LOGF = (const float*)(a.ws + WS_LOGF); float* CUM = (float*)(a.ws + WS_CUM);
    LAS float* wt = (LAS float*)lds;
    for (int bh = blockIdx.x; bh < 128; bh += G) {
        const f32x4* src = (const f32x4*)(LOGF + (size_t)bh * SEQ + tid * 8);
        f32x4 a0 = src[0], a1 = src[1];
        a0.y += a0.x; a0.z += a0.y; a0.w += a0.z; a1.x += a0.w; a1.y += a1.x; a1.z += a1.y; a1.w += a1.z;
        const float tot = a1.w; float sc = tot;
#pragma unroll
        for (int o = 1; o < 64; o <<= 1) { const float n = __shfl_up(sc, o); if (lane >= o) sc += n; }
        if (lane == 63) wt[wave] = sc;
        __syncthreads();
        float off = sc - tot;
        for (int w8 = 0; w8 < wave; ++w8) off += wt[w8];
        a0 += off; a1 += off;
        f32x4* dst = (f32x4*)(CUM + (size_t)bh * SEQ + tid * 8);
        dst[0] = a0; dst[1] = a1;
        __syncthreads();
    }
}

__device__ __forceinline__ void dbg_dump(const Args& a, const bf16* src, int pitch, int col0, int tid, int G) {
    for (size_t i = (size_t)blockIdx.x * 512 + tid; i < (size_t)T * DM; i += (size_t)G * 512) { const size_t t = i >> 10; const int c = (int)(i & 1023);
        a.out[i] = __uint_as_float((unsigned)src[t * pitch + col0 + c] << 16); }
}
__global__ void __launch_bounds__(512, 2) mega_fwd(Args a) {
    extern __shared__ __attribute__((aligned(16))) unsigned char lds_raw[];
    LAS unsigned char* lds = (LAS unsigned char*)lds_raw;
    cg::grid_group grid = cg::this_grid();
    const int tid = threadIdx.x, lane = tid & 63, wave = __builtin_amdgcn_readfirstlane(tid >> 6);
    const int G = gridDim.x, bx = blockIdx.x;
    unsigned char* ws = a.ws;
    const int lo = a.ph_lo, hi = a.ph_hi;
#define IN(k) (lo <= (k) && (k) < hi)
#define SEAM(k) do { if (IN(k) && IN((k) + 1)) { asm volatile("s_waitcnt vmcnt(0) lgkmcnt(0)" ::: "memory"); __syncthreads(); grid.sync(); asm volatile("s_waitcnt vmcnt(0)" ::: "memory"); __syncthreads(); } } while (0)
    bf16* H = (bf16*)(ws + WS_H); bf16* QKV = (bf16*)(ws + WS_QKV); bf16* GATES = (bf16*)(ws + WS_GATES); bf16* YSB = (bf16*)(ws + WS_YSB); bf16* YFX = (bf16*)(ws + WS_YFX); bf16* ACT = (bf16*)(ws + WS_ACT);
    const float* mod = (const float*)(ws + WS_MOD);

    if (IN(0)) phase_prologue(a, lds, tid, lane, wave, G);
    SEAM(0);
#ifndef DUP_P1
#define DUP_P1 1
#endif
    if (IN(1)) for (int rep_ = 0; rep_ < DUP_P1; ++rep_) norm_pass<0>(a, lds, tid, lane, wave, G);
    SEAM(1);
#if defined(DBG_DUMP) && DBG_DUMP == 1
    dbg_dump(a, H, 1024, 0, tid, G); return;
#endif
    if (IN(2)) {
        scan_phase(a, lds, tid, lane, wave, G);
        pg8::Gemm g{H, (const bf16*)(ws + WS_WIN), T, NIN, DM}; pg8::StaticOrder S; S.init(T, NIN, G, bx);
        pg8::EpiIn E{QKV, GATES, a.in[7], QSCALE};
        pg8::gemm_phase<pg8::EpiIn, pg8::StaticOrder, true, true>(lds, g, S, E);
    }
    SEAM(2);
#if defined(DBG_DUMP) && DBG_DUMP == 2
    dbg_dump(a, QKV, 3072, 0, tid, G); return;
#endif
#if defined(DBG_DUMP) && DBG_DUMP == 3
    dbg_dump(a, QKV, 3072, 2048, tid, G); return;
#endif
#if defined(DBG_DUMP) && DBG_DUMP == 4
    dbg_dump(a, GATES, 2048, 0, tid, G); return;
#endif
#ifndef DUP_ATT
#define DUP_ATT 1
#endif
    if (IN(3)) for (int rep_ = 0; rep_ < DUP_ATT; ++rep_) {
        const int vcu = (G % 8 == 0) ? (bx % 8) * (G / 8) + bx / 8 : bx;
        const float* CUM = (const float*)(ws + WS_CUM);
        for (int vc = vcu; vc < 256; vc += G) {
            const int bh = vc >> 1, half = vc & 1, b = bh >> 3, h = bh & 7;
            att::fox_kmax(b, h, QKV + 2048, lds);
#ifndef DUP_FX
#define DUP_FX 1
#endif
            for (int rf_ = 0; rf_ < DUP_FX; ++rf_)
            for (int i = 0; i < 8; ++i) { const int s = 2 * (i >> 1) + half, qb = (i & 1) ? 15 - s : s;
                att::attn_unit<false>(b, h, qb, QKV + 1536, QKV + 2048, QKV + 2560, CUM + (size_t)bh * SEQ, YFX, lds); }
#ifndef DUP_SB
#define DUP_SB 1
#endif
            for (int rs_ = 0; rs_ < DUP_SB; ++rs_)
            { LAS unsigned* ctr = (LAS unsigned*)(lds + 131072);
              __syncthreads();
              if (tid == 0) *ctr = 0u;
              __syncthreads();
              for (;;) {
                  unsigned idx = 0u;
                  if (lane == 0) idx = __hip_atomic_fetch_add(ctr, 1u, __ATOMIC_RELAXED, __HIP_MEMORY_SCOPE_WORKGROUP);
                  idx = (unsigned)__builtin_amdgcn_readfirstlane((int)idx);
                  if (idx >= 64u) break;
                  att::sb_wave_block(b, h, 127 - (2 * (int)idx + half), QKV, QKV + 512, QKV + 1024, YSB, lds + wave * 16384);
              }
              __syncthreads(); }
        }
    }
    SEAM(3);
    if (IN(4)) {
        pg8::Gemm g{YSB, (const bf16*)(ws + WS_WSB), T, DM, 512}; pg8::StaticOrder S; S.init(T, DM, G, bx);
        pg8::EpiBranch<true> E{H, GATES, 0};
        pg8::gemm_phase<pg8::EpiBranch<true>, pg8::StaticOrder, true, true>(lds, g, S, E);
    }
    if (IN(5)) {
        pg8::Gemm g{YFX, (const bf16*)(ws + WS_WFX), T, DM, 512}; pg8::StaticOrder S; S.init(T, DM, G, bx);
        pg8::EpiBranch<false> E{H, GATES, 1024};
        pg8::gemm_phase<pg8::EpiBranch<false>, pg8::StaticOrder, true, true>(lds, g, S, E);
    }
    SEAM(5);
#if defined(DBG_DUMP) && DBG_DUMP == 5
    dbg_dump(a, H, 1024, 0, tid, G); return;
#endif
    if (IN(6)) {
        pg8::Gemm g{H, (const bf16*)(ws + WS_WOUT), T, DM, DM}; pg8::StaticOrder S; S.init(T, DM, G, bx);
        pg8::EpiResidBf<false> E{a.in[0], nullptr, YSB, mod + 2 * DM};
        pg8::gemm_phase<pg8::EpiResidBf<false>, pg8::StaticOrder, true, true>(lds, g, S, E);
    }
    SEAM(6);
    if (IN(7)) norm_pass<1>(a, lds, tid, lane, wave, G);
    SEAM(7);
#ifndef DUP_P8
#define DUP_P8 1
#endif
    if (IN(8)) for (int rep_ = 0; rep_ < DUP_P8; ++rep_) {
        pg8::Gemm g{H, (const bf16*)(ws + WS_WGU), T, 2 * DFF, DM}; pg8::StaticOrder S; S.init(T, 2 * DFF, G, bx);
        pg8::EpiSwiglu E{ACT};
        pg8::gemm_phase<pg8::EpiSwiglu, pg8::StaticOrder, true, true>(lds, g, S, E);
    }
    SEAM(8);
    if (IN(9)) {
        pg8::Gemm g{ACT, (const bf16*)(ws + WS_WDN), T, DM, DFF}; pg8::StaticOrder S; S.init(T, DM, G, bx);
        pg8::EpiResidBf<true> E{nullptr, YSB, H, mod + 5 * DM};
        pg8::gemm_phase<pg8::EpiResidBf<true>, pg8::StaticOrder, true, true>(lds, g, S, E);
    }
    SEAM(9);
    if (IN(10)) norm_pass<2>(a, lds, tid, lane, wave, G);
#undef IN
#undef SEAM
}

extern "C" void kernel_launch(void* const* d_in, const int* in_sizes, int n_in, void* d_out, int out_size, void* d_ws, size_t ws_size, hipStream_t stream) {
    static int grid = 0;
    if (grid == 0) {
        if (n_in != 16 || in_sizes[0] != T * DM || out_size != T * DM || ws_size < WS_END) { fprintf(stderr, "kernel_launch: unexpected shapes (n_in %d, in0 %d, out %d, ws %zu)\n", n_in, n_in > 0 ? in_sizes[0] : -1, out_size, ws_size); grid = -1; return; }
        int dev = 0, cus = 0, per_cu = 0;
        if (hipGetDevice(&dev) != hipSuccess || hipDeviceGetAttribute(&cus, hipDeviceAttributeMultiprocessorCount, dev) != hipSuccess) { grid = -1; return; }
        if (hipFuncSetAttribute((const void*)mega_fwd, hipFuncAttributeMaxDynamicSharedMemorySize, LDS_BYTES) != hipSuccess) { fprintf(stderr, "kernel_launch: hipFuncSetAttribute failed\n"); grid = -1; return; }
        if (hipOccupancyMaxActiveBlocksPerMultiprocessor(&per_cu, (const void*)mega_fwd, 512, LDS_BYTES) != hipSuccess || per_cu < 1) { fprintf(stderr, "kernel_launch: occupancy query says %d\n", per_cu); per_cu = 1; }
        (void)hipGetLastError();
        grid = cus * per_cu;
    }
    if (grid < 0) return;
    Args a{};
    for (int i = 0; i < 16; ++i) a.in[i] = (const float*)d_in[i];
    a.out = (float*)d_out; a.ws = (unsigned char*)d_ws;
#ifndef MK_SPLIT
#define MK_SPLIT 0
#endif
    for (int p0 = 0; p0 < NPHASE; p0 += (MK_SPLIT ? 1 : NPHASE)) {
        a.ph_lo = p0; a.ph_hi = MK_SPLIT ? p0 + 1 : NPHASE;
        void* args[] = {&a};
        const hipError_t e = hipLaunchCooperativeKernel((const void*)mega_fwd, dim3(grid), dim3(512), args, LDS_BYTES, stream);
        if (e != hipSuccess) fprintf(stderr, "kernel_launch: cooperative launch failed: %s (grid %d)\n", hipGetErrorString(e), grid);
    }
}
```

```cpp
#include <hip/hip_runtime.h>
#include <hip/hip_cooperative_groups.h>
#include <cstdio>
#include <cstdint>
namespace cg = cooperative_groups;
namespace pg8 {
#define PG8_LAS __attribute__((address_space(3)))
typedef unsigned short bf16_t;
typedef short bf16x8 __attribute__((ext_vector_type(8)));
typedef float f32x4 __attribute__((ext_vector_type(4)));
typedef unsigned u32x4 __attribute__((ext_vector_type(4)));
constexpr int BM = 256, BK = 64, HALF = 128, HTB = HALF * BK * 2  , STAGE_BYTES = 8 * HTB, NXCD = 8, WGM = 8;

__host__ __device__ __forceinline__ int lds_byte(int r, int c) { const int st = (r >> 4) * 2 + (c >> 5), rr = r & 15, cc = c & 31, ob = rr * 64 + cc * 2; return st * 1024 + (ob ^ (((ob >> 9) & 1) << 5)); }
__host__ __device__ __forceinline__ void stage_rc(int b, int& R, int& C) { const int st = b / 1024, sb = b % 1024, swz = sb ^ (((sb >> 9) & 1) << 5); R = (st >> 1) * 16 + swz / 64; C = (st & 1) * 32 + (swz % 64) / 2; }
__host__ __device__ __forceinline__ int perm32(int rho) { const int n = rho >> 4, i = rho & 15; return 8 * (i >> 2) + 4 * n + (i & 3); }

struct Unit { int pm, pn; };
struct Gemm { const bf16_t* A; const bf16_t* Bt; int M, N, K; };

struct StaticOrder {
    int nM, nN, nwg, G, c;
    __host__ __device__ void init(int M, int N, int G_, int c_) { nM = M / BM; nN = N / BM; nwg = nM * nN; G = G_; c = c_; }
    __host__ __device__ bool next(int i, Unit& u) const {
        const long L = (long)i * G + c; if (L >= nwg) return false;
        int wgid = (int)L; { const int q = nwg / NXCD, r = nwg % NXCD, xcd = wgid % NXCD, off = wgid / NXCD; wgid = (xcd < r ? xcd * (q + 1) : r * (q + 1) + (xcd - r) * q) + off; }
        const int nig = WGM * nN, gid = wgid / nig, fm = gid * WGM, gsz = (nM - fm) < WGM ? (nM - fm) : WGM;
        u.pm = fm + ((wgid % nig) % gsz); u.pn = (wgid % nig) / gsz; return true;
    }
    __device__ __forceinline__ void a_ready(const Unit&) const {}
    __device__ __forceinline__ void done(const Unit&) const {}
};

typedef float f32x2_cv __attribute__((ext_vector_type(2))); typedef __bf16 bf16x2_cv __attribute__((ext_vector_type(2)));
__device__ __forceinline__ unsigned cvt_pk_bf16(float lo, float hi) { f32x2_cv v = {lo, hi}; bf16x2_cv b = __builtin_convertvector(v, bf16x2_cv); return __builtin_bit_cast(unsigned, b); }
typedef unsigned u32x2 __attribute__((ext_vector_type(2)));
__device__ __forceinline__ float bf_lo(unsigned w) { return __uint_as_float(w << 16); }
__device__ __forceinline__ float bf_hi(unsigned w) { return __uint_as_float(w & 0xffff0000u); }
__device__ __forceinline__ float fast_sigmoid(float x) { return __builtin_amdgcn_rcpf(1.f + __builtin_amdgcn_exp2f(-1.4426950409f * x)); }
__device__ __forceinline__ u32x4 pack8(f32x4 v0, f32x4 v1) { u32x4 w; w.x = cvt_pk_bf16(v0[0], v0[1]); w.y = cvt_pk_bf16(v0[2], v0[3]); w.z = cvt_pk_bf16(v1[0], v1[1]); w.w = cvt_pk_bf16(v1[2], v1[3]); return w; }

struct EpiIn {
    static constexpr bool PERM = true, AFTER_DRAIN = false;
    bf16_t* qkv; bf16_t* gates; const float* b_gate; float qscale;
    __device__ __forceinline__ void operator()(const f32x4 (&acc)[2][2][4][2], const Unit& u, int wr, int wc, int fr, int fq) const {
        const int row0 = u.pm * BM + wr * 64 + fr;
        if (u.pn < 12) {
            const float sc = (u.pn < 2 || (u.pn >= 6 && u.pn < 8)) ? qscale : 1.f;
            const int col0 = u.pn * BM + wc * 32 + 8 * fq;
#pragma unroll
            for (int ai = 0; ai < 2; ++ai)
#pragma unroll
                for (int m = 0; m < 4; ++m) { bf16_t* rowp = qkv + (size_t)(row0 + ai * HALF + m * 16) * 3072 + col0;
#pragma unroll
                    for (int bj = 0; bj < 2; ++bj) *(u32x4*)(rowp + bj * HALF) = pack8(acc[ai][bj][m][0] * sc, acc[ai][bj][m][1] * sc); }
        } else {
            const int col0 = (u.pn - 12) * BM + wc * 32 + 8 * fq;
            f32x4 bv[2][2];
#pragma unroll
            for (int bj = 0; bj < 2; ++bj)
#pragma unroll
                for (int n = 0; n < 2; ++n) bv[bj][n] = *(const f32x4*)(b_gate + col0 + bj * HALF + 4 * n);
#pragma unroll
            for (int ai = 0; ai < 2; ++ai)
#pragma unroll
                for (int m = 0; m < 4; ++m) { bf16_t* rowp = gates + (size_t)(row0 + ai * HALF + m * 16) * 2048 + col0;
#pragma unroll
                    for (int bj = 0; bj < 2; ++bj) { f32x4 v0 = acc[ai][bj][m][0] + bv[bj][0], v1 = acc[ai][bj][m][1] + bv[bj][1];
#ifndef DBG_NOSIG
#pragma unroll
                        for (int e = 0; e < 4; ++e) { v0[e] = fast_sigmoid(v0[e]); v1[e] = fast_sigmoid(v1[e]); }
#endif
                        *(u32x4*)(rowp + bj * HALF) = pack8(v0, v1); } }
        }
    }
};
template <bool FIRST> struct EpiBranch {
    static constexpr bool PERM = true, AFTER_DRAIN = false;
    bf16_t* merged; const bf16_t* gates; int goff;
    __device__ __forceinline__ void operator()(const f32x4 (&acc)[2][2][4][2], const Unit& u, int wr, int wc, int fr, int fq) const {
        const int row0 = u.pm * BM + wr * 64 + fr, col0 = u.pn * BM + wc * 32 + 8 * fq;
#pragma unroll
        for (int ai = 0; ai < 2; ++ai)
#pragma unroll
            for (int m = 0; m < 4; ++m) { const size_t row = (size_t)(row0 + ai * HALF + m * 16);
#pragma unroll
                for (int bj = 0; bj < 2; ++bj) { const int c = col0 + bj * HALF;
                    const u32x4 gw = *(const u32x4*)(gates + row * 2048 + goff + c);
                    f32x4 g0 = {bf_lo(gw.x), bf_hi(gw.x), bf_lo(gw.y), bf_hi(gw.y)}, g1 = {bf_lo(gw.z), bf_hi(gw.z), bf_lo(gw.w), bf_hi(gw.w)};
                    f32x4 v0 = g0 * acc[ai][bj][m][0], v1 = g1 * acc[ai][bj][m][1];
                    if (!FIRST) { const u32x4 pw = *(const u32x4*)(merged + row * 1024 + c);
                        v0 += (f32x4){bf_lo(pw.x), bf_hi(pw.x), bf_lo(pw.y), bf_hi(pw.y)}; v1 += (f32x4){bf_lo(pw.z), bf_hi(pw.z), bf_lo(pw.w), bf_hi(pw.w)}; }
                    *(u32x4*)(merged + row * 1024 + c) = pack8(v0, v1); } }
    }
};
struct EpiResid {
    static constexpr bool PERM = false, AFTER_DRAIN = false;
    const float* base; float* out; const float* gate;
    __device__ __forceinline__ void operator()(const f32x4 (&acc)[2][2][4][2], const Unit& u, int wr, int wc, int fr, int fq) const {
        const int row0 = u.pm * BM + wr * 64 + fr, col0 = u.pn * BM + wc * 32 + 4 * fq, b = (u.pm * BM) >> 12;
        f32x4 gv[2][2];
#pragma unroll
        for (int bj = 0; bj < 2; ++bj)
#pragma unroll
            for (int n = 0; n < 2; ++n) gv[bj][n] = *(const f32x4*)(gate + (size_t)b * 6144 + col0 + bj * HALF + n * 16);
#pragma unroll
        for (int ai = 0; ai < 2; ++ai)
#pragma unroll
            for (int m = 0; m < 4; ++m) { const size_t off = (size_t)(row0 + ai * HALF + m * 16) * 1024 + col0;
#pragma unroll
                for (int bj = 0; bj < 2; ++bj)
#pragma unroll
                    for (int n = 0; n < 2; ++n) { const f32x4 bs = *(const f32x4*)(base + off + bj * HALF + n * 16);
                        *(f32x4*)(out + off + bj * HALF + n * 16) = bs + gv[bj][n] * acc[ai][bj][m][n]; } }
    }
};
template <bool BF_BASE> struct EpiResidBf {
    static constexpr bool PERM = true, AFTER_DRAIN = false;
    const float* basef; const bf16_t* baseb; bf16_t* out; const float* gate;
    __device__ __forceinline__ void operator()(const f32x4 (&acc)[2][2][4][2], const Unit& u, int wr, int wc, int fr, int fq) const {
        const int row0 = u.pm * BM + wr * 64 + fr, col0 = u.pn * BM + wc * 32 + 8 * fq, b = (u.pm * BM) >> 12;
        f32x4 gv[2][2];
#pragma unroll
        for (int bj = 0; bj < 2; ++bj)
#pragma unroll
            for (int n = 0; n < 2; ++n) gv[bj][n] = *(const f32x4*)(gate + (size_t)b * 6144 + col0 + bj * HALF + 4 * n);
#pragma unroll
        for (int ai = 0; ai < 2; ++ai)
#pragma unroll
            for (int m = 0; m < 4; ++m) { const size_t off = (size_t)(row0 + ai * HALF + m * 16) * 1024 + col0;
#pragma unroll
                for (int bj = 0; bj < 2; ++bj) { f32x4 v0 = gv[bj][0] * acc[ai][bj][m][0], v1 = gv[bj][1] * acc[ai][bj][m][1];
                    if (BF_BASE) { const u32x4 w = *(const u32x4*)(baseb + off + bj * HALF);
                        v0 += (f32x4){bf_lo(w.x), bf_hi(w.x), bf_lo(w.y), bf_hi(w.y)}; v1 += (f32x4){bf_lo(w.z), bf_hi(w.z), bf_lo(w.w), bf_hi(w.w)}; }
                    else { v0 += *(const f32x4*)(basef + off + bj * HALF); v1 += *(const f32x4*)(basef + off + bj * HALF + 4); }
                    *(u32x4*)(out + off + bj * HALF) = pack8(v0, v1); } }
    }
};
struct EpiSwiglu {
    static constexpr bool PERM = true, AFTER_DRAIN = false;
    bf16_t* A;
    __device__ __forceinline__ void operator()(const f32x4 (&acc)[2][2][4][2], const Unit& u, int wr, int wc, int fr, int fq) const {
        const int row0 = u.pm * BM + wr * 64 + fr, col0 = u.pn * HALF + wc * 32 + 8 * fq;
#pragma unroll
        for (int ai = 0; ai < 2; ++ai)
#pragma unroll
            for (int m = 0; m < 4; ++m) { bf16_t* rowp = A + (size_t)(row0 + ai * HALF + m * 16) * 2816 + col0;
                f32x4 r0, r1;
#pragma unroll
                for (int e = 0; e < 4; ++e) { const float g0 = acc[ai][0][m][0][e], g1 = acc[ai][0][m][1][e];
                    r0[e] = g0 * fast_sigmoid(g0) * acc[ai][1][m][0][e]; r1[e] = g1 * fast_sigmoid(g1) * acc[ai][1][m][1][e]; }
                *(u32x4*)rowp = pack8(r0, r1); }
    }
};

template <class Epi, class Sched, bool ALIGN_EPI = false, bool SP2 = false, bool MIDHOOK = false>
__device__ __forceinline__ void gemm_phase(PG8_LAS unsigned char* lds, const Gemm g, const Sched& S, const Epi& E) {
    const int tid = threadIdx.x, wid = __builtin_amdgcn_readfirstlane(tid >> 6), lane = tid & 63, wr = wid >> 2, wc = wid & 3, fr = lane & 15, fq = lane >> 4;
    const int K = g.K, nt = K / BK;
    unsigned voffA[2], voffB[2];
#pragma unroll
    for (int i = 0; i < 2; ++i) { int R, C; stage_rc(tid * 16 + i * 8192, R, C); const int Rb = Epi::PERM ? ((R & ~31) + perm32(R & 31)) : R;
        voffA[i] = (unsigned)(R * K + C) * 2u; voffB[i] = (unsigned)(Rb * K + C) * 2u; }
    const size_t kstep = (size_t)(BK * 2);
    const size_t hstep = (size_t)HALF * K * 2;
    const size_t tstep = 2 * hstep;
    const unsigned ldsw = (unsigned)wid * 1024u;
    const int aoff = lds_byte(wr * 64 + fr, fq * 8), boff = lds_byte(wc * 32 + fr, fq * 8);
#define PG8_SA(b, h) (((b) * 2 + (h)) * HTB)
#define PG8_SB(b, h) ((4 + (b) * 2 + (h)) * HTB)
#define PG8_STAGE(bufoff, gbase, voff) do { _Pragma("unroll") for (int _i = 0; _i < 2; ++_i) \
        __builtin_amdgcn_global_load_lds((const unsigned*)((const char*)(gbase) + (voff)[_i]), (PG8_LAS unsigned*)(lds + (bufoff) + ldsw + _i * 8192), 16, 0, 0); } while (0)
#define PG8_LDA(dst, b, h) do { _Pragma("unroll") for (int m = 0; m < 4; ++m) _Pragma("unroll") for (int k = 0; k < 2; ++k) dst[m][k] = *(const PG8_LAS bf16x8*)(lds + PG8_SA(b, h) + aoff + m * 2048 + k * 1024); } while (0)
#define PG8_LDB(dst, b, h) do { _Pragma("unroll") for (int n = 0; n < 2; ++n) _Pragma("unroll") for (int k = 0; k < 2; ++k) dst[n][k] = *(const PG8_LAS bf16x8*)(lds + PG8_SB(b, h) + boff + n * 2048 + k * 1024); } while (0)
#define PG8_MMA(ai, bj, At, Bt) do { __builtin_amdgcn_s_setprio(1); _Pragma("unroll") for (int m = 0; m < 4; ++m) _Pragma("unroll") for (int n = 0; n < 2; ++n) _Pragma("unroll") for (int k = 0; k < 2; ++k) \
        acc[ai][bj][m][n] = __builtin_amdgcn_mfma_f32_16x16x32_bf16(Bt[n][k], At[m][k], acc[ai][bj][m][n], 0, 0, 0); __builtin_amdgcn_s_setprio(0); } while (0)
#define PG8_WAIT_V(n) asm volatile("s_waitcnt vmcnt(" #n ")" ::: "memory")
#define PG8_WAIT_L(n) asm volatile("s_waitcnt lgkmcnt(" #n ")" ::: "memory")
#define PG8_BAR __builtin_amdgcn_s_barrier()
#define PG8_SCHED __builtin_amdgcn_sched_barrier(0)
    Unit cur, nxt; int ui = 0;
    if (!S.next(0, cur)) return;
    f32x4 acc[2][2][4][2];
#pragma unroll
    for (int a = 0; a < 2; ++a)
#pragma unroll
        for (int b = 0; b < 2; ++b)
#pragma unroll
            for (int m = 0; m < 4; ++m)
#pragma unroll
                for (int n = 0; n < 2; ++n) acc[a][b][m][n] = (f32x4){0.f, 0.f, 0.f, 0.f};
    bf16x8 At[4][2], B0[2][2], B1[2][2];
    const char* cA = (const char*)g.A + (size_t)cur.pm * tstep; const char* cB = (const char*)g.Bt + (size_t)cur.pn * tstep;
    S.a_ready(cur);
    if constexpr (SP2) {
        PG8_STAGE(PG8_SB(0, 0), cB, voffB); PG8_STAGE(PG8_SB(0, 1), cB + hstep, voffB); PG8_STAGE(PG8_SA(0, 0), cA, voffA); PG8_STAGE(PG8_SA(0, 1), cA + hstep, voffA);
        if (wr == 1) PG8_BAR;
        PG8_WAIT_V(2); PG8_BAR;
        PG8_STAGE(PG8_SB(1, 0), cB + kstep, voffB); PG8_STAGE(PG8_SA(1, 0), cA + kstep, voffA); PG8_STAGE(PG8_SB(1, 1), cB + hstep + kstep, voffB);
        PG8_WAIT_V(6); PG8_BAR;
    } else {
        PG8_STAGE(PG8_SB(0, 0), cB, voffB); PG8_STAGE(PG8_SA(0, 0), cA, voffA); PG8_STAGE(PG8_SB(0, 1), cB + hstep, voffB); PG8_STAGE(PG8_SA(0, 1), cA + hstep, voffA);
        if (wr == 1) PG8_BAR;
        PG8_WAIT_V(4); PG8_BAR;
        PG8_STAGE(PG8_SB(1, 0), cB + kstep, voffB); PG8_STAGE(PG8_SA(1, 0), cA + kstep, voffA); PG8_STAGE(PG8_SB(1, 1), cB + hstep + kstep, voffB);
        PG8_WAIT_V(6); PG8_BAR;
    }
    for (;;) {
        const bool has_next = S.next(ui + 1, nxt);
        const char* nA = has_next ? (const char*)g.A + (size_t)nxt.pm * tstep : cA; const char* nB = has_next ? (const char*)g.Bt + (size_t)nxt.pn * tstep : cB;
        for (int t = 0; t < nt; t += 2) {
            const bool last = (t == nt - 2);
            const char* a1 = cA + (size_t)(t + 1) * kstep;
            const char* a2 = last ? nA : cA + (size_t)(t + 2) * kstep; const char* b2 = last ? nB : cB + (size_t)(t + 2) * kstep;
            const char* a3 = a2 + kstep; const char* b3 = b2 + kstep;
            if (last && has_next) S.a_ready(nxt);
            if constexpr (SP2) {
            PG8_LDB(B0, 0, 0); PG8_LDB(B1, 0, 1); PG8_SCHED; PG8_LDA(At, 0, 0); PG8_STAGE(PG8_SA(1, 1), a1 + hstep, voffA);
            PG8_WAIT_V(8); PG8_WAIT_L(0); PG8_BAR; PG8_MMA(0, 0, At, B0); PG8_MMA(0, 1, At, B1); PG8_BAR; PG8_SCHED;
            PG8_LDA(At, 0, 1); PG8_STAGE(PG8_SB(0, 0), b2, voffB); PG8_STAGE(PG8_SB(0, 1), b2 + hstep, voffB); PG8_STAGE(PG8_SA(0, 0), a2, voffA);
            PG8_WAIT_V(8); PG8_WAIT_L(0); PG8_BAR; PG8_MMA(1, 0, At, B0); PG8_MMA(1, 1, At, B1); PG8_BAR; PG8_SCHED;
            PG8_LDB(B0, 1, 0); PG8_LDB(B1, 1, 1); PG8_SCHED; PG8_LDA(At, 1, 0); PG8_STAGE(PG8_SA(0, 1), a2 + hstep, voffA);
            PG8_WAIT_V(8); PG8_WAIT_L(0); PG8_BAR; PG8_MMA(0, 0, At, B0); PG8_MMA(0, 1, At, B1); PG8_BAR; PG8_SCHED;
            PG8_LDA(At, 1, 1); PG8_STAGE(PG8_SB(1, 0), b3, voffB); PG8_STAGE(PG8_SB(1, 1), b3 + hstep, voffB); PG8_STAGE(PG8_SA(1, 0), a3, voffA);
            PG8_WAIT_V(8); PG8_WAIT_L(0); PG8_BAR; PG8_MMA(1, 0, At, B0); PG8_MMA(1, 1, At, B1); PG8_BAR; PG8_SCHED;
            } else {
            PG8_LDB(B0, 0, 0); PG8_SCHED; PG8_LDA(At, 0, 0); PG8_STAGE(PG8_SA(1, 1), a1 + hstep, voffA);
            PG8_WAIT_L(8); PG8_BAR; PG8_WAIT_L(0); PG8_MMA(0, 0, At, B0); PG8_BAR; PG8_SCHED;
            PG8_LDB(B1, 0, 1); PG8_STAGE(PG8_SB(0, 0), b2, voffB);
            PG8_BAR; PG8_WAIT_L(0); PG8_MMA(0, 1, At, B1); PG8_BAR;
            PG8_LDA(At, 0, 1); PG8_STAGE(PG8_SA(0, 0), a2, voffA);
            PG8_BAR; PG8_WAIT_L(0); PG8_MMA(1, 0, At, B0); PG8_BAR; PG8_SCHED;
            PG8_STAGE(PG8_SB(0, 1), b2 + hstep, voffB);
            PG8_WAIT_V(6); PG8_BAR; PG8_MMA(1, 1, At, B1); PG8_BAR;
            PG8_LDB(B0, 1, 0); PG8_SCHED; PG8_LDA(At, 1, 0); PG8_STAGE(PG8_SA(0, 1), a2 + hstep, voffA);
            PG8_WAIT_L(8); PG8_BAR; PG8_WAIT_L(0); PG8_MMA(0, 0, At, B0); PG8_BAR; PG8_SCHED;
            PG8_LDB(B1, 1, 1); PG8_STAGE(PG8_SB(1, 0), b3, voffB);
            PG8_BAR; PG8_WAIT_L(0); PG8_MMA(0, 1, At, B1); PG8_BAR;
            PG8_LDA(At, 1, 1); PG8_STAGE(PG8_SA(1, 0), a3, voffA);
            PG8_BAR; PG8_WAIT_L(0); PG8_MMA(1, 0, At, B0); PG8_BAR; PG8_SCHED;
            PG8_STAGE(PG8_SB(1, 1), b3 + hstep, voffB);
            PG8_WAIT_V(6); PG8_BAR; PG8_MMA(1, 1, At, B1); PG8_BAR;
            }
            if constexpr (MIDHOOK) { if (t + 2 == Epi::mid_tiles) { E.mid(acc, cur, wr, wc, fr, fq); PG8_SCHED; } }
        }
        if constexpr (ALIGN_EPI) { if (wr == 0) PG8_BAR; }
        if constexpr (!Epi::AFTER_DRAIN) { E(acc, cur, wr, wc, fr, fq); S.done(cur); }
        if (!has_next) break;
#pragma unroll
        for (int a = 0; a < 2; ++a)
#pragma unroll
            for (int b = 0; b < 2; ++b)
#pragma unroll
                for (int m = 0; m < 4; ++m)
#pragma unroll
                    for (int n = 0; n < 2; ++n) acc[a][b][m][n] = (f32x4){0.f, 0.f, 0.f, 0.f};
        cur = nxt; cA = nA; cB = nB; ++ui;
        if constexpr (ALIGN_EPI) { if (wr == 1) PG8_BAR; }
    }
    PG8_WAIT_V(0);
    if constexpr (!ALIGN_EPI) { if (wr == 0) PG8_BAR; }
    PG8_BAR;
    if constexpr (Epi::AFTER_DRAIN) { E.fused(acc, cur, wr, wc, fr, fq, lds, wid, lane); S.done(cur); }
#undef PG8_SA
#undef PG8_SB
#undef PG8_STAGE
#undef PG8_LDA
#undef PG8_LDB
#undef PG8_MMA
#undef PG8_WAIT_V
#undef PG8_WAIT_L
#undef PG8_BAR
#undef PG8_SCHED
}
}

namespace att {
typedef unsigned short bf16_t;
typedef short bf16x8 __attribute__((ext_vector_type(8)));
typedef short s16x4 __attribute__((ext_vector_type(4)));
typedef float f32x16 __attribute__((ext_vector_type(16)));
typedef float f32x4 __attribute__((ext_vector_type(4)));
typedef unsigned u32x4 __attribute__((ext_vector_type(4)));
typedef unsigned u32x2 __attribute__((ext_vector_type(2)));
#define ALAS __attribute__((address_space(3)))
constexpr int SEQ = 4096, PITCH = 3072, SLOTB = 8192;
constexpr int NSLOT = 3, L_K = 0, L_V = NSLOT * SLOTB, L_CK = 2 * NSLOT * SLOTB, L_FLAG = L_CK + 16384, L_KMAX = L_FLAG + 64, L_RED = L_KMAX + 64, L_END = L_RED + 64;
constexpr float LOG2E = 1.4426950408889634f;
constexpr float FX_DONE = -152.f;
constexpr float SB_DONE = -160.f;
__device__ __forceinline__ int crow(int r, int hi) { return (r & 3) + 8 * (r >> 2) + 4 * hi; }
__device__ __forceinline__ void glds16(const void* gsrc, unsigned lds_dst) { unsigned keep;
    asm volatile("s_mov_b32 %0, m0\n\ts_mov_b32 m0, %2\n\ts_nop 0\n\tglobal_load_lds_dwordx4 %1, off\n\ts_mov_b32 m0, %0" : "=&s"(keep) : "v"(gsrc), "s"(lds_dst) : "memory"); }
typedef float f32x2_t __attribute__((ext_vector_type(2))); typedef __bf16 bf16x2_t __attribute__((ext_vector_type(2)));
__device__ __forceinline__ unsigned cvtpk(float lo, float hi) { f32x2_t v = {lo, hi}; bf16x2_t b = __builtin_convertvector(v, bf16x2_t); return __builtin_bit_cast(unsigned, b); }
typedef short v4i16_t __attribute__((ext_vector_type(4)));
__device__ __forceinline__ s16x4 vtr(const ALAS unsigned char* p) { return __builtin_bit_cast(s16x4, __builtin_amdgcn_ds_read_tr16_b64_v4i16((ALAS v4i16_t*)p)); }
#define ATT_WAIT_BAR(N) asm volatile("s_waitcnt vmcnt(" #N ") lgkmcnt(0)\n\ts_barrier" ::: "memory")
#define ATT_BAR() asm volatile("s_waitcnt lgkmcnt(0)\n\ts_barrier" ::: "memory")


__device__ __forceinline__ void fox_kmax(int b, int h, const bf16_t* K, ALAS unsigned char* shm) {
    const int tid = threadIdx.x, lane = tid & 63, wid = __builtin_amdgcn_readfirstlane(tid >> 6);
    float mx = 0.f;
    for (int r = tid; r < SEQ; r += 512) {
        const bf16_t* kr = K + ((long)b * SEQ + r) * PITCH + h * 64;
        float s = 0.f;
#pragma unroll
        for (int c = 0; c < 8; ++c) { const u32x4 w = *(const u32x4*)(kr + 8 * c);
#pragma unroll
            for (int e = 0; e < 4; ++e) { const float lo = __uint_as_float(w[e] << 16), hi = __uint_as_float(w[e] & 0xffff0000u); s += lo * lo + hi * hi; } }
        mx = fmaxf(mx, s);
    }
#pragma unroll
    for (int o = 1; o < 64; o <<= 1) mx = fmaxf(mx, __shfl_xor(mx, o));
    ALAS float* red = (ALAS float*)(shm + L_RED);
    if (lane == 0) red[wid] = mx;
    __syncthreads();
    if (tid == 0) { float m = red[0];
#pragma unroll
        for (int w = 1; w < 8; ++w) m = fmaxf(m, red[w]);
        *(ALAS float*)(shm + L_KMAX) = sqrtf(m); }
    __syncthreads();
}

template <bool SB>
__device__ __forceinline__ void attn_unit(int b, int h, int qb, const bf16_t* Q, const bf16_t* K, const bf16_t* V, const float* cum, bf16_t* O, ALAS unsigned char* shm) {
    const int tid = threadIdx.x, lane = tid & 63, r32 = lane & 31, hi = lane >> 5;
    const int wid = __builtin_amdgcn_readfirstlane(tid >> 6);
    const long rowbase = (long)b * SEQ; const int q0 = qb * 256;
    const int wq0 = q0 + wid * 32, qrow = wq0 + r32;
    const unsigned lds0 = (unsigned)(uintptr_t)shm;
    ALAS float* ck = (ALAS float*)(shm + L_CK);
    ALAS unsigned* flag = (ALAS unsigned*)(shm + L_FLAG);
    const int NT = (q0 + 256) / 64;
    const bf16_t* ksrc = K + (rowbase + lane) * PITCH + h * 64 + wid * 8;
    const bf16_t* vsrc = V + (rowbase + 16 * (wid & 3) + (lane >> 2)) * PITCH + h * 64 + (wid >> 2) * 32 + (lane & 3) * 8;
    const unsigned kdst = lds0 + L_K + wid * 1024, vdst = lds0 + L_V + wid * 1024;
#define ATT_DMA(t, so) do { glds16(ksrc + (long)(t) * 64 * PITCH, (unsigned)__builtin_amdgcn_readfirstlane(kdst + (so))); glds16(vsrc + (long)(t) * 64 * PITCH, (unsigned)__builtin_amdgcn_readfirstlane(vdst + (so))); } while (0)
    ATT_DMA(NT - 1, 0); ATT_DMA(NT - 2, SLOTB);
    bf16x8 qr[4];
    { const bf16_t* Qw = Q + (rowbase + qrow) * PITCH + h * 64 + hi * 8;
#pragma unroll
      for (int d0 = 0; d0 < 4; ++d0) qr[d0] = *(const bf16x8*)(Qw + d0 * 16); }
    float cq2 = 0.f, qkb = 0.f;
    if (!SB) {
        for (int i = tid; i < q0 + 256; i += 512) ck[i] = cum[i] * LOG2E;
        cq2 = cum[qrow] * LOG2E;
        float s = 0.f;
#pragma unroll
        for (int d0 = 0; d0 < 4; ++d0) { const u32x4 w = __builtin_bit_cast(u32x4, qr[d0]);
#pragma unroll
            for (int e = 0; e < 4; ++e) { const float lo = __uint_as_float(w[e] << 16), hh = __uint_as_float(w[e] & 0xffff0000u); s += lo * lo + hh * hh; } }
        { auto rr = __builtin_amdgcn_permlane32_swap(__float_as_uint(s), __float_as_uint(s), false, false); s = __uint_as_float(rr[0]) + __uint_as_float(rr[1]); }
        qkb = sqrtf(s) * (*(const ALAS float*)(shm + L_KMAX)) * 1.01f + 0.5f;
    }
    f32x16 o0 = {}, o1 = {};
    float mref = 0.f, l_run = 0.f, carry = SB ? 1.f : 0.f;
    bool started = false, wdone = false;
    const ALAS unsigned char* kp0 = shm + L_K + hi * 1024 + r32 * 16;
    const ALAS unsigned char* vp0 = shm + L_V + ((lane >> 4) & 1) * 32 + (lane & 3) * 8 + (4 * hi + ((lane & 15) >> 2)) * 64;
    int so = 0;
    for (int t = NT - 1; t >= 0; --t) {
        if (t > 0) { ATT_WAIT_BAR(2); } else { ATT_WAIT_BAR(0); }
        if (t < NT - 1) {
            const ALAS unsigned* fp = flag + ((t + 1) & 1) * 8;
            const u32x4 f0 = *(const ALAS u32x4*)fp, f1 = *(const ALAS u32x4*)(fp + 4);
            const unsigned all = f0.x & f0.y & f0.z & f0.w & f1.x & f1.y & f1.z & f1.w;
            if (__builtin_amdgcn_readfirstlane(all) != 0u) break;
        }
        if (t >= 2) { const int sn = (so == 0) ? 2 * SLOTB : so - SLOTB; ATT_DMA(t - 2, sn); }
        const int kv0 = 64 * t;
        if (kv0 <= wq0 + 31 && !wdone) {
            const bool needmask = (kv0 + 63 >= wq0);
            const ALAS unsigned char* kp = kp0 + so;
            f32x16 p0, p1;
            if (!SB) {
                const float base = cq2 - mref;
                const ALAS float* ckp = ck + kv0 + 4 * hi;
#pragma unroll
                for (int g = 0; g < 4; ++g) { const f32x4 c0 = *(const ALAS f32x4*)(ckp + 8 * g), c1 = *(const ALAS f32x4*)(ckp + 32 + 8 * g);
#pragma unroll
                    for (int e = 0; e < 4; ++e) { p0[4 * g + e] = base - c0[e]; p1[4 * g + e] = base - c1[e]; } }
            } else { p0 = f32x16{}; p1 = f32x16{}; }
#pragma unroll
            for (int d0 = 0; d0 < 4; ++d0) {
                const bf16x8 b0 = *(const ALAS bf16x8*)(kp + d0 * 2048), b1 = *(const ALAS bf16x8*)(kp + d0 * 2048 + 512);
                p0 = __builtin_amdgcn_mfma_f32_32x32x16_bf16(b0, qr[d0], p0, 0, 0, 0);
                p1 = __builtin_amdgcn_mfma_f32_32x32x16_bf16(b1, qr[d0], p1, 0, 0, 0);
            }
            if (!SB) {
                if (needmask) {
#pragma unroll
                    for (int r = 0; r < 16; ++r) { const int kv = kv0 + crow(r, hi); if (kv > qrow) p0[r] = -INFINITY; if (kv + 32 > qrow) p1[r] = -INFINITY; }
                }
                float mx = fmaxf(fmaxf(p0[0], p1[0]), fmaxf(p0[1], p1[1]));
#pragma unroll
                for (int r = 2; r < 16; r += 2) mx = fmaxf(fmaxf(mx, p0[r]), fmaxf(p1[r], fmaxf(p0[r + 1], p1[r + 1])));
                { auto rr = __builtin_amdgcn_permlane32_swap(__float_as_uint(mx), __float_as_uint(mx), false, false); mx = fmaxf(__uint_as_float(rr[0]), __uint_as_float(rr[1])); }
                if (__any(mx > 0.f) || !started) {
                    const float dl = started ? fmaxf(mx, 0.f) : mx;
                    mref += dl;
                    const float alpha = started ? __builtin_amdgcn_exp2f(-dl) : 0.f;
                    l_run *= alpha;
#pragma unroll
                    for (int r = 0; r < 16; ++r) { p0[r] -= dl; p1[r] -= dl; o0[r] *= alpha; o1[r] *= alpha; }
                    started = true;
                }
                float s0 = 0.f, s1 = 0.f;
#pragma unroll
                for (int r = 0; r < 16; ++r) { p0[r] = __builtin_amdgcn_exp2f(p0[r]); p1[r] = __builtin_amdgcn_exp2f(p1[r]); s0 += p0[r]; s1 += p1[r]; }
                l_run += s0 + s1;
                wdone = __all(qkb + cq2 - ck[kv0] - mref < FX_DONE);
            } else {
                f32x16 K0, K1;
#pragma unroll
                for (int r = 0; r < 16; ++r) {
                    const float e0 = __builtin_amdgcn_exp2f(fminf(p0[r], 120.f)), e1 = __builtin_amdgcn_exp2f(fminf(p1[r], 120.f));
                    float k0 = __builtin_amdgcn_rcpf(1.f + e0), k1 = __builtin_amdgcn_rcpf(1.f + e1);
                    float b0 = e0 * k0, b1 = e1 * k1;
                    if (needmask) { const int kv = kv0 + crow(r, hi); if (kv >= qrow) { k0 = 1.f; b0 = 0.f; } if (kv + 32 >= qrow) { k1 = 1.f; b1 = 0.f; } }
                    K0[r] = k0; K1[r] = k1; p0[r] = b0; p1[r] = b1;
                }
                float lo[8], hv[8];
#pragma unroll
                for (int g = 0; g < 4; ++g) {
                    const float g0 = (K0[4 * g] * K0[4 * g + 1]) * (K0[4 * g + 2] * K0[4 * g + 3]);
                    const float g1 = (K1[4 * g] * K1[4 * g + 1]) * (K1[4 * g + 2] * K1[4 * g + 3]);
                    auto r0 = __builtin_amdgcn_permlane32_swap(__float_as_uint(g0), __float_as_uint(g0), false, false);
                    auto r1 = __builtin_amdgcn_permlane32_swap(__float_as_uint(g1), __float_as_uint(g1), false, false);
                    lo[g] = __uint_as_float(r0[0]); hv[g] = __uint_as_float(r0[1]); lo[4 + g] = __uint_as_float(r1[0]); hv[4 + g] = __uint_as_float(r1[1]);
                }
                float E[8]; float R = carry;
#pragma unroll
                for (int i = 7; i >= 0; --i) { const float eh = R; R *= hv[i]; const float el = R; R *= lo[i]; E[i] = hi ? eh : el; }
                carry = R;
#pragma unroll
                for (int g = 0; g < 4; ++g) {
                    float run0 = E[g], run1 = E[4 + g];
#pragma unroll
                    for (int e = 3; e >= 0; --e) { const int r = 4 * g + e;
                        p0[r] *= run0; p1[r] *= run1; run0 *= K0[r]; run1 *= K1[r]; }
                }
                wdone = __all(carry == 0.f);
            }
            u32x4 w;
            bf16x8 pa[4];
            w = (u32x4){cvtpk(p0[0], p0[1]), cvtpk(p0[2], p0[3]), cvtpk(p0[4], p0[5]), cvtpk(p0[6], p0[7])}; pa[0] = __builtin_bit_cast(bf16x8, w);
            w = (u32x4){cvtpk(p0[8], p0[9]), cvtpk(p0[10], p0[11]), cvtpk(p0[12], p0[13]), cvtpk(p0[14], p0[15])}; pa[1] = __builtin_bit_cast(bf16x8, w);
            w = (u32x4){cvtpk(p1[0], p1[1]), cvtpk(p1[2], p1[3]), cvtpk(p1[4], p1[5]), cvtpk(p1[6], p1[7])}; pa[2] = __builtin_bit_cast(bf16x8, w);
            w = (u32x4){cvtpk(p1[8], p1[9]), cvtpk(p1[10], p1[11]), cvtpk(p1[12], p1[13]), cvtpk(p1[14], p1[15])}; pa[3] = __builtin_bit_cast(bf16x8, w);
            const ALAS unsigned char* vp = vp0 + so;
#pragma unroll
            for (int s = 0; s < 4; ++s) {
                const s16x4 a0 = vtr(vp + s * 1024), a1 = vtr(vp + s * 1024 + 512), c0 = vtr(vp + 4096 + s * 1024), c1 = vtr(vp + 4096 + s * 1024 + 512);
                const bf16x8 v0 = {a0[0], a0[1], a0[2], a0[3], a1[0], a1[1], a1[2], a1[3]}, v1 = {c0[0], c0[1], c0[2], c0[3], c1[0], c1[1], c1[2], c1[3]};
                o0 = __builtin_amdgcn_mfma_f32_32x32x16_bf16(v0, pa[s], o0, 0, 0, 0);
                o1 = __builtin_amdgcn_mfma_f32_32x32x16_bf16(v1, pa[s], o1, 0, 0, 0);
            }
        }
        if (lane == 0) flag[(t & 1) * 8 + wid] = wdone ? 1u : 0u;
        so = (so == 2 * SLOTB) ? 0 : so + SLOTB;
    }
    asm volatile("s_waitcnt vmcnt(0) lgkmcnt(0)\n\ts_barrier" ::: "memory");
    float inv = 1.f;
    if (!SB) { auto rr = __builtin_amdgcn_permlane32_swap(__float_as_uint(l_run), __float_as_uint(l_run), false, false); inv = 1.f / (__uint_as_float(rr[0]) + __uint_as_float(rr[1])); }
    bf16_t* Ow = O + (rowbase + qrow) * 512 + h * 64 + 4 * hi;
#pragma unroll
    for (int g = 0; g < 4; ++g) {
        u32x2 w0, w1;
        w0.x = cvtpk(o0[4 * g] * inv, o0[4 * g + 1] * inv); w0.y = cvtpk(o0[4 * g + 2] * inv, o0[4 * g + 3] * inv);
        w1.x = cvtpk(o1[4 * g] * inv, o1[4 * g + 1] * inv); w1.y = cvtpk(o1[4 * g + 2] * inv, o1[4 * g + 3] * inv);
        *(u32x2*)(Ow + 8 * g) = w0; *(u32x2*)(Ow + 32 + 8 * g) = w1;
    }
#undef ATT_DMA
}

constexpr int FOX_NS = 4, FL_K = 0, FL_V = FOX_NS * SLOTB, FL_CK = 2 * FOX_NS * SLOTB, FL_FLAG = FL_CK + 16384, FL_KMAX = FL_FLAG + 64, FL_RED = FL_KMAX + 64, FL_END = FL_RED + 64;
__device__ __forceinline__ void fox_kmax2(int b, int h, const bf16_t* K, ALAS unsigned char* shm) {
    const int tid = threadIdx.x, lane = tid & 63, wid = __builtin_amdgcn_readfirstlane(tid >> 6);
    float mx = 0.f;
    for (int r = tid; r < SEQ; r += 512) {
        const bf16_t* kr = K + ((long)b * SEQ + r) * PITCH + h * 64;
        float s = 0.f;
#pragma unroll
        for (int c = 0; c < 8; ++c) { const u32x4 w = *(const u32x4*)(kr + 8 * c);
#pragma unroll
            for (int e = 0; e < 4; ++e) { const float lo = __uint_as_float(w[e] << 16), hi = __uint_as_float(w[e] & 0xffff0000u); s += lo * lo + hi * hi; } }
        mx = fmaxf(mx, s);
    }
#pragma unroll
    for (int o = 1; o < 64; o <<= 1) mx = fmaxf(mx, __shfl_xor(mx, o));
    ALAS float* red = (ALAS float*)(shm + FL_RED);
    __syncthreads();
    if (lane == 0) red[wid] = mx;
    __syncthreads();
    if (tid == 0) { float m = red[0];
#pragma unroll
        for (int w = 1; w < 8; ++w) m = fmaxf(m, red[w]);
        *(ALAS float*)(shm + FL_KMAX) = sqrtf(m); }
    __syncthreads();
}
__device__ __forceinline__ void fox_unit(int b, int h, int qb, const bf16_t* Q, const bf16_t* K, const bf16_t* V, const float* cum, bf16_t* O, ALAS unsigned char* shm) {
    const int tid = threadIdx.x, lane = tid & 63, r32 = lane & 31, hi = lane >> 5;
    const int wid = __builtin_amdgcn_readfirstlane(tid >> 6);
    const long rowbase = (long)b * SEQ; const int q0 = qb * 256;
    const int wq0 = q0 + wid * 32, qrow = wq0 + r32;
    const unsigned lds0 = (unsigned)(uintptr_t)shm;
    ALAS float* ck = (ALAS float*)(shm + FL_CK);
    ALAS unsigned* flag = (ALAS unsigned*)(shm + FL_FLAG);
    const int NT = (q0 + 256) / 64;
    const bf16_t* ksrc = K + (rowbase + lane) * PITCH + h * 64 + wid * 8;
    const bf16_t* vsrc = V + (rowbase + 16 * (wid & 3) + (lane >> 2)) * PITCH + h * 64 + (wid >> 2) * 32 + (lane & 3) * 8;
    const unsigned kdst = lds0 + FL_K + wid * 1024, vdst = lds0 + FL_V + wid * 1024;
#define FOX_DMA(t, so) do { glds16(ksrc + (long)(t) * 64 * PITCH, (unsigned)__builtin_amdgcn_readfirstlane(kdst + (so))); glds16(vsrc + (long)(t) * 64 * PITCH, (unsigned)__builtin_amdgcn_readfirstlane(vdst + (so))); } while (0)
    FOX_DMA(NT - 1, 0); FOX_DMA(NT - 2, SLOTB); FOX_DMA(NT - 3, 2 * SLOTB);
    bf16x8 qr[4];
    { const bf16_t* Qw = Q + (rowbase + qrow) * PITCH + h * 64 + hi * 8;
#pragma unroll
      for (int d0 = 0; d0 < 4; ++d0) qr[d0] = *(const bf16x8*)(Qw + d0 * 16); }
    for (int i = tid; i < q0 + 256; i += 512) ck[i] = cum[i] * LOG2E;
    const float cq2 = cum[qrow] * LOG2E;
    float qkb;
    { float s = 0.f;
#pragma unroll
      for (int d0 = 0; d0 < 4; ++d0) { const u32x4 w = __builtin_bit_cast(u32x4, qr[d0]);
#pragma unroll
          for (int e = 0; e < 4; ++e) { const float lo = __uint_as_float(w[e] << 16), hh = __uint_as_float(w[e] & 0xffff0000u); s += lo * lo + hh * hh; } }
      { auto rr = __builtin_amdgcn_permlane32_swap(__float_as_uint(s), __float_as_uint(s), false, false); s = __uint_as_float(rr[0]) + __uint_as_float(rr[1]); }
      qkb = sqrtf(s) * (*(const ALAS float*)(shm + FL_KMAX)) * 1.01f + 0.5f; }
    f32x16 o0 = {}, o1 = {};
    f32x16 sC0 = {}, sC1 = {}, sN0 = {}, sN1 = {};
    float mref = 0.f, sref = 0.f, srefN = 0.f, l_run = 0.f;
    bool started = false, wdone = false;
    const ALAS unsigned char* kp0 = shm + FL_K + hi * 1024 + r32 * 16;
    const ALAS unsigned char* vp0 = shm + FL_V + ((lane >> 4) & 1) * 32 + (lane & 3) * 8 + (4 * hi + ((lane & 15) >> 2)) * 64;
#define FOX_QK(D0, D1, tt, so_, ref_) do { const float base_ = cq2 - (ref_); const ALAS float* ckp_ = ck + 64 * (tt) + 4 * hi; \
        _Pragma("unroll") for (int g = 0; g < 4; ++g) { const f32x4 c0_ = *(const ALAS f32x4*)(ckp_ + 8 * g), c1_ = *(const ALAS f32x4*)(ckp_ + 32 + 8 * g); \
            _Pragma("unroll") for (int e = 0; e < 4; ++e) { D0[4 * g + e] = base_ - c0_[e]; D1[4 * g + e] = base_ - c1_[e]; } } \
        const ALAS unsigned char* kp_ = kp0 + (so_); \
        _Pragma("unroll") for (int d0 = 0; d0 < 4; ++d0) { const bf16x8 b0_ = *(const ALAS bf16x8*)(kp_ + d0 * 2048), b1_ = *(const ALAS bf16x8*)(kp_ + d0 * 2048 + 512); \
            D0 = __builtin_amdgcn_mfma_f32_32x32x16_bf16(b0_, qr[d0], D0, 0, 0, 0); D1 = __builtin_amdgcn_mfma_f32_32x32x16_bf16(b1_, qr[d0], D1, 0, 0, 0); } } while (0)
    ATT_WAIT_BAR(4);
    if (64 * (NT - 1) <= wq0 + 31) { FOX_QK(sC0, sC1, NT - 1, 0, 0.f); }
    int so = 0;
    for (int t = NT - 1; t >= 0; --t) {
        if (t >= 2) { ATT_WAIT_BAR(3); } else if (t == 1) { ATT_WAIT_BAR(1); } else { ATT_WAIT_BAR(0); }
        if (t < NT - 1) {
            const ALAS unsigned* fp = flag + ((t + 1) & 1) * 8;
            const u32x4 f0 = *(const ALAS u32x4*)fp, f1 = *(const ALAS u32x4*)(fp + 4);
            const unsigned all = f0.x & f0.y & f0.z & f0.w & f1.x & f1.y & f1.z & f1.w;
            if (__builtin_amdgcn_readfirstlane(all) != 0u) break;
        }
        const int so1 = (so == (FOX_NS - 1) * SLOTB) ? 0 : so + SLOTB;
        if (t >= 3) { const int sp = (so == 0) ? (FOX_NS - 1) * SLOTB : so - SLOTB; FOX_DMA(t - 3, sp); }
        const bool actN = (t >= 1) && (64 * (t - 1) <= wq0 + 31) && !wdone;
        const bool actC = (64 * t <= wq0 + 31) && !wdone;
        if (actN) { FOX_QK(sN0, sN1, t - 1, so1, mref); srefN = mref; }
        if (actC) {
            const int kv0 = 64 * t;
            if (kv0 + 63 >= wq0) {
#pragma unroll
                for (int r = 0; r < 16; ++r) { const int kv = kv0 + crow(r, hi); if (kv > qrow) sC0[r] = -INFINITY; if (kv + 32 > qrow) sC1[r] = -INFINITY; }
            }
            float mx = fmaxf(fmaxf(sC0[0], sC1[0]), fmaxf(sC0[1], sC1[1]));
#pragma unroll
            for (int r = 2; r < 16; r += 2) mx = fmaxf(fmaxf(mx, sC0[r]), fmaxf(sC1[r], fmaxf(sC0[r + 1], sC1[r + 1])));
            { auto rr = __builtin_amdgcn_permlane32_swap(__float_as_uint(mx), __float_as_uint(mx), false, false); mx = fmaxf(__uint_as_float(rr[0]), __uint_as_float(rr[1])); }
            const float mt = mx + sref;
            const float mnew = started ? fmaxf(mref, mt) : mt;
            const float adj = sref - mnew;
            if (__any(adj != 0.f) || !started) {
                const float alpha = started ? __builtin_amdgcn_exp2f(mref - mnew) : 0.f;
                l_run *= alpha;
#pragma unroll
                for (int r = 0; r < 16; ++r) { sC0[r] += adj; sC1[r] += adj; o0[r] *= alpha; o1[r] *= alpha; }
                started = true;
            }
            mref = mnew;
            float s0 = 0.f, s1 = 0.f;
#pragma unroll
            for (int r = 0; r < 16; ++r) { sC0[r] = __builtin_amdgcn_exp2f(sC0[r]); sC1[r] = __builtin_amdgcn_exp2f(sC1[r]); s0 += sC0[r]; s1 += sC1[r]; }
            l_run += s0 + s1;
            u32x4 w; bf16x8 pa[4];
            w = (u32x4){cvtpk(sC0[0], sC0[1]), cvtpk(sC0[2], sC0[3]), cvtpk(sC0[4], sC0[5]), cvtpk(sC0[6], sC0[7])}; pa[0] = __builtin_bit_cast(bf16x8, w);
            w = (u32x4){cvtpk(sC0[8], sC0[9]), cvtpk(sC0[10], sC0[11]), cvtpk(sC0[12], sC0[13]), cvtpk(sC0[14], sC0[15])}; pa[1] = __builtin_bit_cast(bf16x8, w);
            w = (u32x4){cvtpk(sC1[0], sC1[1]), cvtpk(sC1[2], sC1[3]), cvtpk(sC1[4], sC1[5]), cvtpk(sC1[6], sC1[7])}; pa[2] = __builtin_bit_cast(bf16x8, w);
            w = (u32x4){cvtpk(sC1[8], sC1[9]), cvtpk(sC1[10], sC1[11]), cvtpk(sC1[12], sC1[13]), cvtpk(sC1[14], sC1[15])}; pa[3] = __builtin_bit_cast(bf16x8, w);
            const ALAS unsigned char* vp = vp0 + so;
#pragma unroll
            for (int s = 0; s < 4; ++s) {
                const s16x4 a0 = vtr(vp + s * 1024), a1 = vtr(vp + s * 1024 + 512), c0 = vtr(vp + 4096 + s * 1024), c1 = vtr(vp + 4096 + s * 1024 + 512);
                const bf16x8 v0 = {a0[0], a0[1], a0[2], a0[3], a1[0], a1[1], a1[2], a1[3]}, v1 = {c0[0], c0[1], c0[2], c0[3], c1[0], c1[1], c1[2], c1[3]};
                o0 = __builtin_amdgcn_mfma_f32_32x32x16_bf16(v0, pa[s], o0, 0, 0, 0);
                o1 = __builtin_amdgcn_mfma_f32_32x32x16_bf16(v1, pa[s], o1, 0, 0, 0);
            }
            wdone = __all(qkb + cq2 - ck[kv0] - mref < FX_DONE);
        }
        sC0 = sN0; sC1 = sN1; sref = srefN;
        if (lane == 0) flag[(t & 1) * 8 + wid] = wdone ? 1u : 0u;
        so = so1;
    }
    asm volatile("s_waitcnt vmcnt(0) lgkmcnt(0)\n\ts_barrier" ::: "memory");
    float inv;
    { auto rr = __builtin_amdgcn_permlane32_swap(__float_as_uint(l_run), __float_as_uint(l_run), false, false); inv = 1.f / (__uint_as_float(rr[0]) + __uint_as_float(rr[1])); }
    bf16_t* Ow = O + (rowbase + qrow) * 512 + h * 64 + 4 * hi;
#pragma unroll
    for (int g = 0; g < 4; ++g) {
        u32x2 w0, w1;
        w0.x = cvtpk(o0[4 * g] * inv, o0[4 * g + 1] * inv); w0.y = cvtpk(o0[4 * g + 2] * inv, o0[4 * g + 3] * inv);
        w1.x = cvtpk(o1[4 * g] * inv, o1[4 * g + 1] * inv); w1.y = cvtpk(o1[4 * g + 2] * inv, o1[4 * g + 3] * inv);
        *(u32x2*)(Ow + 8 * g) = w0; *(u32x2*)(Ow + 32 + 8 * g) = w1;
    }
#undef FOX_DMA
#undef FOX_QK
}

__device__ __forceinline__ void sb_wave_block(int b, int h, int j, const bf16_t* Q, const bf16_t* K, const bf16_t* V, bf16_t* O, ALAS unsigned char* wl) {
    const int lane = threadIdx.x & 63, r32 = lane & 31, hi = lane >> 5;
    const long rowbase = (long)b * SEQ; const int qrow = 32 * j + r32;
    const unsigned l0 = (unsigned)(uintptr_t)wl;
    const bf16_t* ksrc = K + (rowbase + (lane & 31)) * PITCH + h * 64 + (lane >> 5) * 8;
    const bf16_t* vsrc = V + (rowbase + (lane >> 2)) * PITCH + h * 64 + (lane & 3) * 8;
#define SBW_DMA(tt, bo) do { const long ro_ = (long)(tt) * 32 * PITCH; \
        _Pragma("unroll") for (int c_ = 0; c_ < 4; ++c_) glds16(ksrc + ro_ + c_ * 16, (unsigned)__builtin_amdgcn_readfirstlane(l0 + (bo) + c_ * 1024)); \
        _Pragma("unroll") for (int p_ = 0; p_ < 4; ++p_) glds16(vsrc + ro_ + (long)(16 * (p_ & 1)) * PITCH + (p_ >> 1) * 32, (unsigned)__builtin_amdgcn_readfirstlane(l0 + (bo) + 4096 + p_ * 1024)); } while (0)
    SBW_DMA(j, 0);
    bf16x8 qr[4];
    { const bf16_t* Qw = Q + (rowbase + qrow) * PITCH + h * 64 + hi * 8;
#pragma unroll
      for (int d0 = 0; d0 < 4; ++d0) qr[d0] = *(const bf16x8*)(Qw + d0 * 16); }
    f32x16 o0 = {}, o1 = {};
    float carry = 1.f;
    const ALAS unsigned char* kp0 = wl + hi * 512 + r32 * 16;
    const ALAS unsigned char* vp0 = wl + 4096 + ((lane >> 4) & 1) * 32 + (lane & 3) * 8 + (4 * hi + ((lane & 15) >> 2)) * 64;
    int bo = 0;
    for (int tt = j; tt >= 0; --tt) {
        asm volatile("s_waitcnt lgkmcnt(0)" ::: "memory");
        if (tt > 0) { SBW_DMA(tt - 1, bo ^ 8192); asm volatile("s_waitcnt vmcnt(8)" ::: "memory"); } else { asm volatile("s_waitcnt vmcnt(0)" ::: "memory"); }
        const int kv0 = 32 * tt;
        const ALAS unsigned char* kp = kp0 + bo;
        f32x16 p0 = {};
#pragma unroll
        for (int d0 = 0; d0 < 4; ++d0) { const bf16x8 kf = *(const ALAS bf16x8*)(kp + d0 * 1024); p0 = __builtin_amdgcn_mfma_f32_32x32x16_bf16(kf, qr[d0], p0, 0, 0, 0); }
        const bool diag = (tt == j);
        f32x16 K0;
#pragma unroll
        for (int r = 0; r < 16; ++r) {
            const float e0 = __builtin_amdgcn_exp2f(fminf(p0[r], 120.f));
            float k0 = __builtin_amdgcn_rcpf(1.f + e0), b0 = e0 * k0;
            if (diag) { const int kv = kv0 + crow(r, hi); if (kv >= qrow) { k0 = 1.f; b0 = 0.f; } }
            K0[r] = k0; p0[r] = b0;
        }
        float lo[4], hv[4];
#pragma unroll
        for (int g = 0; g < 4; ++g) { const float g0 = (K0[4 * g] * K0[4 * g + 1]) * (K0[4 * g + 2] * K0[4 * g + 3]);
            auto r0 = __builtin_amdgcn_permlane32_swap(__float_as_uint(g0), __float_as_uint(g0), false, false);
            lo[g] = __uint_as_float(r0[0]); hv[g] = __uint_as_float(r0[1]); }
        float E[4]; float R = carry;
#pragma unroll
        for (int i = 3; i >= 0; --i) { const float eh = R; R *= hv[i]; const float el = R; R *= lo[i]; E[i] = hi ? eh : el; }
        carry = R;
#pragma unroll
        for (int g = 0; g < 4; ++g) { float run0 = E[g];
#pragma unroll
            for (int e = 3; e >= 0; --e) { const int r = 4 * g + e; p0[r] *= run0; run0 *= K0[r]; } }
        u32x4 w; bf16x8 pa[2];
        w = (u32x4){cvtpk(p0[0], p0[1]), cvtpk(p0[2], p0[3]), cvtpk(p0[4], p0[5]), cvtpk(p0[6], p0[7])}; pa[0] = __builtin_bit_cast(bf16x8, w);
        w = (u32x4){cvtpk(p0[8], p0[9]), cvtpk(p0[10], p0[11]), cvtpk(p0[12], p0[13]), cvtpk(p0[14], p0[15])}; pa[1] = __builtin_bit_cast(bf16x8, w);
        const ALAS unsigned char* vp = vp0 + bo;
#pragma unroll
        for (int s = 0; s < 2; ++s) {
            const s16x4 a0 = vtr(vp + s * 1024), a1 = vtr(vp + s * 1024 + 512), c0 = vtr(vp + 2048 + s * 1024), c1 = vtr(vp + 2048 + s * 1024 + 512);
            const bf16x8 v0 = {a0[0], a0[1], a0[2], a0[3], a1[0], a1[1], a1[2], a1[3]}, v1 = {c0[0], c0[1], c0[2], c0[3], c1[0], c1[1], c1[2], c1[3]};
            o0 = __builtin_amdgcn_mfma_f32_32x32x16_bf16(v0, pa[s], o0, 0, 0, 0);
            o1 = __builtin_amdgcn_mfma_f32_32x32x16_bf16(v1, pa[s], o1, 0, 0, 0);
        }
        bo ^= 8192;
        if (__all(carry == 0.f)) break;
    }
    asm volatile("s_waitcnt vmcnt(0) lgkmcnt(0)" ::: "memory");
    bf16_t* Ow = O + (rowbase + qrow) * 512 + h * 64 + 4 * hi;
#pragma unroll
    for (int g = 0; g < 4; ++g) {
        u32x2 w0, w1;
        w0.x = cvtpk(o0[4 * g], o0[4 * g + 1]); w0.y = cvtpk(o0[4 * g + 2], o0[4 * g + 3]);
        w1.x = cvtpk(o1[4 * g], o1[4 * g + 1]); w1.y = cvtpk(o1[4 * g + 2], o1[4 * g + 3]);
        *(u32x2*)(Ow + 8 * g) = w0; *(u32x2*)(Ow + 32 + 8 * g) = w1;
    }
#undef SBW_DMA
}
}


#define LAS __attribute__((address_space(3)))
typedef unsigned short bf16;
typedef float f32x4 __attribute__((ext_vector_type(4)));
typedef unsigned u32x4v __attribute__((ext_vector_type(4)));
typedef unsigned u32x2v __attribute__((ext_vector_type(2)));
constexpr int NB = 16, SEQ = 4096, DM = 1024, T = NB * SEQ, DFF = 2816, DINP = 5128, NIN = 5120, NMOD = 6144;
constexpr float RMS_EPS = 1e-6f;
constexpr float QSCALE = 0.125f * 1.4426950408889634f;
constexpr size_t MiB = 1u << 20;
constexpr size_t WS_MOD = 1 * MiB, WS_LOGF = 2 * MiB, WS_CUM = 4 * MiB, WS_WIN = 8 * MiB, WS_WSB = 18 * MiB, WS_WFX = 19 * MiB, WS_WOUT = 20 * MiB, WS_WGU = 22 * MiB, WS_WDN = 34 * MiB;
constexpr size_t WS_H = 64 * MiB, WS_YSB = 192 * MiB, WS_YFX = 256 * MiB, WS_GATES = 320 * MiB, WS_QKV = 576 * MiB, WS_ACT = 576 * MiB, WS_END = 960 * MiB;
constexpr int LDS_BYTES = 147456;
constexpr int NPHASE = 11;

struct Args { const float* in[16]; float* out; unsigned char* ws; int ph_lo, ph_hi; };

__device__ __forceinline__ float wave_sum(float v) {
#pragma unroll
    for (int o = 1; o < 64; o <<= 1) v += __shfl_xor(v, o);
    return v;
}
__device__ __forceinline__ unsigned f2bf(float f) { unsigned u = __builtin_bit_cast(unsigned, f); return (u + 0x7fffu + ((u >> 16) & 1u)) >> 16; }
__device__ __forceinline__ unsigned pk2(float lo, float hi) { return f2bf(lo) | (f2bf(hi) << 16); }

__device__ __forceinline__ void transpose_item(const float* W, int ldw, int K, int src_col0, bf16* WT, int dst_row0, int k0, LAS float* scr, int lane) {
#pragma unroll 8
    for (int i = 0; i < 32; ++i) { const int kk = 2 * i + (lane >> 5); scr[kk * 33 + (lane & 31)] = W[(size_t)(k0 + kk) * ldw + src_col0 + (lane & 31)]; }
    asm volatile("s_waitcnt lgkmcnt(0)" ::: "memory");
    const int c = lane & 7;
#pragma unroll
    for (int j = 0; j < 4; ++j) { const int n = (lane >> 3) + 8 * j; const LAS float* s = scr + (8 * c) * 33 + n;
        u32x4v o; o.x = pk2(s[0 * 33], s[1 * 33]); o.y = pk2(s[2 * 33], s[3 * 33]); o.z = pk2(s[4 * 33], s[5 * 33]); o.w = pk2(s[6 * 33], s[7 * 33]);
        *(u32x4v*)(WT + (size_t)(dst_row0 + n) * K + k0 + 8 * c) = o; }
    asm volatile("s_waitcnt lgkmcnt(0)" ::: "memory");
}

__device__ __forceinline__ void phase_prologue(const Args& a, LAS unsigned char* lds, int tid, int lane, int wave, int G) {
    unsigned char* ws = a.ws;
    float* mod = (float*)(ws + WS_MOD);
    for (int item = blockIdx.x; item < NMOD / 64; item += G) {
        LAS float* sc = (LAS float*)lds;
        LAS float* red = (LAS float*)(lds + 65536);
        const float* c = a.in[1];
        for (int i = tid; i < NB * DM; i += 512) { const int b = i >> 10, k = i & 1023; const float v = c[i]; sc[k * 16 + b] = v / (1.f + __expf(-v)); }
        __syncthreads();
        const float* w = a.in[2] + item * 64 + lane;
        float acc[16];
#pragma unroll
        for (int b = 0; b < 16; ++b) acc[b] = 0.f;
        const int k0 = wave * 128;
#pragma unroll 4
        for (int k = k0; k < k0 + 128; ++k) {
            const float wv = w[(size_t)k * NMOD];
            const LAS f32x4* s4 = (const LAS f32x4*)(sc + k * 16);
#pragma unroll
            for (int q = 0; q < 4; ++q) { const f32x4 s = s4[q]; acc[4 * q] += s.x * wv; acc[4 * q + 1] += s.y * wv; acc[4 * q + 2] += s.z * wv; acc[4 * q + 3] += s.w * wv; }
        }
#pragma unroll
        for (int b = 0; b < 16; ++b) red[(wave * 16 + b) * 64 + lane] = acc[b];
        __syncthreads();
        for (int o = tid; o < 1024; o += 512) { const int b = o >> 6, l = o & 63; float s = 0.f;
#pragma unroll
            for (int w8 = 0; w8 < 8; ++w8) s += red[(w8 * 16 + b) * 64 + l];
            mod[b * NMOD + item * 64 + l] = s + a.in[3][item * 64 + l]; }
        __syncthreads();
    }
    LAS float* scr = (LAS float*)(lds + wave * 16384);
    const int gw = blockIdx.x * 8 + wave, NGW = G * 8;
    bf16* WIN = (bf16*)(ws + WS_WIN); bf16* WSB = (bf16*)(ws + WS_WSB); bf16* WFX = (bf16*)(ws + WS_WFX); bf16* WOUT = (bf16*)(ws + WS_WOUT); bf16* WGU = (bf16*)(ws + WS_WGU); bf16* WDN = (bf16*)(ws + WS_WDN);
    constexpr int I0 = 16 * 96, I1 = 16 * 64, I2 = 8 * 32, I3 = 8 * 32, I4 = 16 * 32, I5 = 16 * 88, I6 = 16 * 88, I7 = 44 * 32;
    constexpr int NITEMS = I0 + I1 + I2 + I3 + I4 + I5 + I6 + I7;
    for (int it = gw; it < NITEMS; it += NGW) {
        int r = it;
        if (r < I0) { const int kb = r / 96, nb = r % 96; transpose_item(a.in[5], DINP, 1024, 32 * nb, WIN, 32 * nb, 64 * kb, scr, lane); continue; } r -= I0;
        if (r < I1) { const int kb = r / 64, nb = r % 64; transpose_item(a.in[5], DINP, 1024, 3080 + 32 * nb, WIN, 3072 + 32 * nb, 64 * kb, scr, lane); continue; } r -= I1;
        if (r < I2) { const int kb = r / 32, nb = r % 32; transpose_item(a.in[8], 1024, 512, 32 * nb, WSB, 32 * nb, 64 * kb, scr, lane); continue; } r -= I2;
        if (r < I3) { const int kb = r / 32, nb = r % 32; transpose_item(a.in[9], 1024, 512, 32 * nb, WFX, 32 * nb, 64 * kb, scr, lane); continue; } r -= I3;
        if (r < I4) { const int kb = r / 32, nb = r % 32; transpose_item(a.in[10], 1024, 1024, 32 * nb, WOUT, 32 * nb, 64 * kb, scr, lane); continue; } r -= I4;
        if (r < I5) { const int kb = r / 88, nb = r % 88, n0 = 32 * nb; transpose_item(a.in[12], DFF, 1024, n0, WGU, (n0 >> 7) * 256 + (n0 & 127), 64 * kb, scr, lane); continue; } r -= I5;
        if (r < I6) { const int kb = r / 88, nb = r % 88, n0 = 32 * nb; transpose_item(a.in[13], DFF, 1024, n0, WGU, (n0 >> 7) * 256 + 128 + (n0 & 127), 64 * kb, scr, lane); continue; } r -= I6;
        { const int kb = r / 32, nb = r % 32; transpose_item(a.in[14], 1024, DFF, 32 * nb, WDN, 32 * nb, 64 * kb, scr, lane); }
    }
}

template <int MODE>
__device__ __forceinline__ void norm_pass(const Args& a, LAS unsigned char* lds, int tid, int lane, int wave, int G) {
    unsigned char* ws = a.ws;
    const float* mod = (const float*)(ws + WS_MOD);
    const float* src = a.in[0];
    const bf16* srcb = MODE == 1 ? (const bf16*)(ws + WS_YSB) : (const bf16*)(ws + WS_H);
    const float* gvec = MODE == 0 ? a.in[4] : (MODE == 1 ? a.in[11] : a.in[15]);
    constexpr int SH = MODE == 0 ? 0 : 3 * DM, SC = MODE == 0 ? DM : 4 * DM;
    bf16* H = (bf16*)(ws + WS_H);
    float* LOGF = (float*)(ws + WS_LOGF);
    LAS float* wfL = (LAS float*)lds;
    if (MODE == 0) {
        for (int i = tid; i < 8192; i += 512) { const int jj = i >> 10, k = i & 1023; wfL[i] = a.in[5][(size_t)k * DINP + 3072 + jj]; }
        __syncthreads();
    }
    const int gw = blockIdx.x * 8 + wave, NGW = G * 8;
    for (int r0 = gw * 32; r0 < T; r0 += NGW * 32) {
        const int b = r0 >> 12;
        f32x4 gs[4], sh[4];
#pragma unroll
        for (int j = 0; j < 4; ++j) { const int col = 4 * lane + 256 * j; const f32x4 g4 = *(const f32x4*)(gvec + col);
            if (MODE < 2) { const f32x4 s4 = *(const f32x4*)(mod + b * NMOD + SC + col); sh[j] = *(const f32x4*)(mod + b * NMOD + SH + col); gs[j] = g4 * (1.f + s4); }
            else { gs[j] = g4; sh[j] = (f32x4){0.f, 0.f, 0.f, 0.f}; } }
        f32x4 vn[4];
#define NP_LOAD(dst, row_) do { if (MODE == 0) { const f32x4* xr_ = (const f32x4*)(src + (size_t)(row_) * DM) + lane; \
                _Pragma("unroll") for (int j = 0; j < 4; ++j) dst[j] = xr_[64 * j]; } \
            else { const u32x2v* xr_ = (const u32x2v*)(srcb + (size_t)(row_) * DM) + lane; \
                _Pragma("unroll") for (int j = 0; j < 4; ++j) { const u32x2v w_ = xr_[64 * j]; \
                    dst[j] = (f32x4){__uint_as_float(w_.x << 16), __uint_as_float(w_.x & 0xffff0000u), __uint_as_float(w_.y << 16), __uint_as_float(w_.y & 0xffff0000u)}; } } } while (0)
        NP_LOAD(vn, r0);
        for (int rr = 0; rr < 32; ++rr) {
            const size_t row = (size_t)r0 + rr;
            f32x4 v[4];
#pragma unroll
            for (int j = 0; j < 4; ++j) v[j] = vn[j];
            if (rr < 31) NP_LOAD(vn, row + 1);
            float ss = 0.f;
#pragma unroll
            for (int j = 0; j < 4; ++j) ss += (v[j].x * v[j].x + v[j].y * v[j].y) + (v[j].z * v[j].z + v[j].w * v[j].w);
            ss = wave_sum(ss);
            const float rstd = 1.0f / sqrtf(ss * (1.0f / DM) + RMS_EPS);
#pragma unroll
            for (int j = 0; j < 4; ++j) v[j] = v[j] * rstd * gs[j] + sh[j];
            if (MODE == 2) { f32x4* o = (f32x4*)(a.out + row * DM) + lane;
#pragma unroll
                for (int j = 0; j < 4; ++j) o[64 * j] = v[j]; }
            else { u32x2v* o = (u32x2v*)(H + row * DM) + lane;
#pragma unroll
                for (int j = 0; j < 4; ++j) { u32x2v w; w.x = pk2(v[j].x, v[j].y); w.y = pk2(v[j].z, v[j].w); o[64 * j] = w; } }
            if (MODE == 0) {
                float f[8];
#pragma unroll
                for (int jj = 0; jj < 8; ++jj) { float s = 0.f;
#pragma unroll
                    for (int j = 0; j < 4; ++j) { const f32x4 w4 = *(const LAS f32x4*)(wfL + jj * 1024 + 4 * lane + 256 * j); s += (v[j].x * w4.x + v[j].y * w4.y) + (v[j].z * w4.z + v[j].w * w4.w); }
                    f[jj] = s; }
                const bool h5 = (lane & 32) != 0, h4 = (lane & 16) != 0, h3 = (lane & 8) != 0;
#pragma unroll
                for (int i = 0; i < 4; ++i) { const float send = h5 ? f[i] : f[i + 4], keep = h5 ? f[i + 4] : f[i]; f[i] = keep + __shfl_xor(send, 32); }
#pragma unroll
                for (int i = 0; i < 2; ++i) { const float send = h4 ? f[i] : f[i + 2], keep = h4 ? f[i + 2] : f[i]; f[i] = keep + __shfl_xor(send, 16); }
                { const float send = h3 ? f[0] : f[1], keep = h3 ? f[1] : f[0]; f[0] = keep + __shfl_xor(send, 8); }
                f[0] += __shfl_xor(f[0], 4); f[0] += __shfl_xor(f[0], 2); f[0] += __shfl_xor(f[0], 1);
                if ((lane & 7) == 0) { const int jj = lane >> 3; const float val = f[0] + a.in[6][jj];
                    LOGF[((size_t)(b * 8 + jj) << 12) + (row & 4095)] = fminf(val, 0.f) - log1pf(__expf(-fabsf(val))); }
            }
        }
    }
}

__device__ __forceinline__ void scan_phase(const Args& a, LAS unsigned char* lds, int tid, int lane, int wave, int G) {
    const float* LOGF = (const float*)(a.ws + WS_LOGF); float* CUM = (float*)(a.ws + WS_CUM);
    LAS float* wt = (LAS float*)lds;
    for (int bh = blockIdx.x; bh < 128; bh += G) {
        const f32x4* src = (const f32x4*)(LOGF + (size_t)bh * SEQ + tid * 8);
        f32x4 a0 = src[0], a1 = src[1];
        a0.y += a0.x; a0.z += a0.y; a0.w += a0.z; a1.x += a0.w; a1.y += a1.x; a1.z += a1.y; a1.w += a1.z;
        const float tot = a1.w; float sc = tot;
#pragma unroll
        for (int o = 1; o < 64; o <<= 1) { const float n = __shfl_up(sc, o); if (lane >= o) sc += n; }
        if (lane == 63) wt[wave] = sc;
        __syncthreads();
        float off = sc - tot;
        for (int w8 = 0; w8 < wave; ++w8) off += wt[w8];
        a0 += off; a1 += off;
        f32x4* dst = (f32x4*)(CUM + (size_t)bh * SEQ + tid * 8);
        dst[0] = a0; dst[1] = a1;
        __syncthreads();
    }
}

__device__ __forceinline__ void dbg_dump(const Args& a, const bf16* src, int pitch, int col0, int tid, int G) {
    for (size_t i = (size_t)blockIdx.x * 512 + tid; i < (size_t)T * DM; i += (size_t)G * 512) { const size_t t = i >> 10; const int c = (int)(i & 1023);
        a.out[i] = __uint_as_float((unsigned)src[t * pitch + col0 + c] << 16); }
}
#define XB_TMO      128
#define XB_XCNT(j)  (256  + 64 * (j))
#define XB_XSUB(j)  (1280 + 64 * (j))
#define XB_XGEN(j)  (2304 + 64 * (j))
#define XB_TOP      3328
#define XB_TOPGEN   3392
#define XCD_BAR_WORDS 3456
#define XB_SPIN_CAP (1u << 18)

__device__ __forceinline__ unsigned xb_ld(unsigned* p)              { return __hip_atomic_load(p, __ATOMIC_RELAXED, __HIP_MEMORY_SCOPE_AGENT); }
__device__ __forceinline__ unsigned xb_add(unsigned* p, unsigned v) { return __hip_atomic_fetch_add(p, v, __ATOMIC_RELAXED, __HIP_MEMORY_SCOPE_AGENT); }
__device__ __forceinline__ unsigned xb_xcc_id() { return (unsigned)__builtin_amdgcn_s_getreg((3 << 11) | 20) & 0xFu; }
#define XB_SPIN(cond, bar) do { unsigned _sp = 0; while (cond) { __builtin_amdgcn_s_sleep(1); \
    if ((++_sp & 255u) == 0u) { if (xb_ld(&(bar)[XB_TMO])) break; if (_sp > XB_SPIN_CAP) { atomicAdd(&(bar)[XB_TMO], 1u); break; } } } } while (0)

struct XcdBarrier {
    unsigned* bar; unsigned x;
    volatile LAS unsigned* st;
};

__device__ __forceinline__ XcdBarrier xcd_barrier_post(unsigned* bar, volatile LAS unsigned* st) {
    XcdBarrier b; b.bar = bar; b.x = xb_xcc_id(); b.st = st;
    if (threadIdx.x == 0) (void)xb_add(&bar[XB_XCNT(b.x)], 1u);
    return b;
}
__device__ __forceinline__ void xcd_barrier_complete(unsigned* bar, unsigned x, unsigned& nloc, unsigned& nx) {
    const unsigned G = gridDim.x * gridDim.y * gridDim.z;
    unsigned sum, cnt, mine, sp = 0u;
    for (;;) {
        sum = 0u; cnt = 0u; mine = 0u;
#pragma unroll
        for (unsigned j = 0; j < 16; ++j) { const unsigned c = xb_ld(&bar[XB_XCNT(j)]); sum += c; cnt += (c > 0u) ? 1u : 0u; mine = (j == x) ? c : mine; }
        if (sum == G) break;
        __builtin_amdgcn_s_sleep(1);
        if ((++sp & 255u) == 0u) { if (xb_ld(&bar[XB_TMO])) break; if (sp > XB_SPIN_CAP) { atomicAdd(&bar[XB_TMO], 1u); break; } }
    }
    nloc = mine > 0u ? mine : 1u; nx = cnt > 0u ? cnt : 1u;
}

__device__ __forceinline__ void xcd_barrier(const XcdBarrier& b) {
    asm volatile("s_waitcnt vmcnt(0)" ::: "memory");
    __syncthreads();
    if (threadIdx.x == 0) {
        unsigned* bar = b.bar;
        __builtin_amdgcn_s_waitcnt(0);
        unsigned nloc = b.st[0], nx = b.st[1];
        if (nloc == 0u) { xcd_barrier_complete(bar, b.x, nloc, nx); b.st[0] = nloc; b.st[1] = nx; }
        const unsigned old = xb_add(&bar[XB_XSUB(b.x)], 1u);
        const unsigned gen = old / nloc;
        if (old + 1u == (gen + 1u) * nloc) {
            __builtin_amdgcn_fence(__ATOMIC_RELEASE, "agent");
            asm volatile("s_waitcnt vmcnt(0)" ::: "memory");
            const unsigned og = xb_add(&bar[XB_TOP], 1u);
            const unsigned tg = og / nx;
            if (og + 1u == (tg + 1u) * nx) xb_add(&bar[XB_TOPGEN], 1u);
            else XB_SPIN(xb_ld(&bar[XB_TOPGEN]) == tg, bar);
            __builtin_amdgcn_fence(__ATOMIC_ACQUIRE, "agent");
            xb_add(&bar[XB_XGEN(b.x)], 1u);
            asm volatile("s_waitcnt vmcnt(0)" ::: "memory");
        } else {
            XB_SPIN(xb_ld(&bar[XB_XGEN(b.x)]) == gen, bar);
            __builtin_amdgcn_fence(__ATOMIC_ACQUIRE, "agent");
            asm volatile("s_waitcnt vmcnt(0)" ::: "memory");
        }
    }
    __syncthreads();
}

__global__ void __launch_bounds__(512, 2) mega_fwd(Args a) {
    extern __shared__ __attribute__((aligned(16))) unsigned char lds_raw[];
    LAS unsigned char* lds = (LAS unsigned char*)lds_raw;
    cg::grid_group grid = cg::this_grid();
    const int tid = threadIdx.x, lane = tid & 63, wave = __builtin_amdgcn_readfirstlane(tid >> 6);
    const int G = gridDim.x, bx = blockIdx.x;
    unsigned char* ws = a.ws;
    const int lo = a.ph_lo, hi = a.ph_hi;
    volatile LAS unsigned* xst = (volatile LAS unsigned*)(lds + 131072 + 64);
    if (tid < 2) xst[tid] = 0u;
    __syncthreads();
    XcdBarrier xbar = xcd_barrier_post((unsigned*)ws, xst);
#define IN(k) (lo <= (k) && (k) < hi)
#define SEAM(k) do { if (IN(k) && IN((k) + 1)) { if ((k) == 0) { asm volatile("s_waitcnt vmcnt(0) lgkmcnt(0)" ::: "memory"); __syncthreads(); grid.sync(); asm volatile("s_waitcnt vmcnt(0)" ::: "memory"); __syncthreads(); } \
        else { xcd_barrier(xbar); } } } while (0)
    bf16* H = (bf16*)(ws + WS_H); bf16* QKV = (bf16*)(ws + WS_QKV); bf16* GATES = (bf16*)(ws + WS_GATES); bf16* YSB = (bf16*)(ws + WS_YSB); bf16* YFX = (bf16*)(ws + WS_YFX); bf16* ACT = (bf16*)(ws + WS_ACT);
    const float* mod = (const float*)(ws + WS_MOD);

#ifndef DUP_P0
#define DUP_P0 1
#endif
    if (IN(0)) for (int rep_ = 0; rep_ < DUP_P0; ++rep_) phase_prologue(a, lds, tid, lane, wave, G);
    SEAM(0);
#ifndef DUP_P1
#define DUP_P1 1
#endif
    if (IN(1)) for (int rep_ = 0; rep_ < DUP_P1; ++rep_) norm_pass<0>(a, lds, tid, lane, wave, G);
    SEAM(1);
#if defined(DBG_DUMP) && DBG_DUMP == 1
    dbg_dump(a, H, 1024, 0, tid, G); return;
#endif
    if (IN(2)) {
        scan_phase(a, lds, tid, lane, wave, G);
        pg8::Gemm g{H, (const bf16*)(ws + WS_WIN), T, NIN, DM}; pg8::StaticOrder S; S.init(T, NIN, G, bx);
        pg8::EpiIn E{QKV, GATES, a.in[7], QSCALE};
        pg8::gemm_phase<pg8::EpiIn, pg8::StaticOrder, true, true>(lds, g, S, E);
    }
    SEAM(2);
#if defined(DBG_DUMP) && DBG_DUMP == 2
    dbg_dump(a, QKV, 3072, 0, tid, G); return;
#endif
#if defined(DBG_DUMP) && DBG_DUMP == 3
    dbg_dump(a, QKV, 3072, 2048, tid, G); return;
#endif
#if defined(DBG_DUMP) && DBG_DUMP == 4
    dbg_dump(a, GATES, 2048, 0, tid, G); return;
#endif
#ifndef DUP_ATT
#define DUP_ATT 1
#endif
    if (IN(3)) for (int rep_ = 0; rep_ < DUP_ATT; ++rep_) {
        const int vcu = (G % 8 == 0) ? (bx % 8) * (G / 8) + bx / 8 : bx;
        const float* CUM = (const float*)(ws + WS_CUM);
        for (int vc = vcu; vc < 256; vc += G) {
            const int bh = vc >> 1, half = vc & 1, b = bh >> 3, h = bh & 7;
            att::fox_kmax(b, h, QKV + 2048, lds);
#ifndef DUP_FX
#define DUP_FX 1
#endif
            for (int rf_ = 0; rf_ < DUP_FX; ++rf_)
            for (int i = 0; i < 8; ++i) { const int s = 2 * (i >> 1) + half, qb = (i & 1) ? 15 - s : s;
                att::attn_unit<false>(b, h, qb, QKV + 1536, QKV + 2048, QKV + 2560, CUM + (size_t)bh * SEQ, YFX, lds); }
#ifndef DUP_SB
#define DUP_SB 1
#endif
            for (int rs_ = 0; rs_ < DUP_SB; ++rs_)
            { LAS unsigned* ctr = (LAS unsigned*)(lds + 131072);
              __syncthreads();
              if (tid == 0) *ctr = 0u;
              __syncthreads();
              for (;;) {
                  unsigned idx = 0u;
                  if (lane == 0) idx = __hip_atomic_fetch_add(ctr, 1u, __ATOMIC_RELAXED, __HIP_MEMORY_SCOPE_WORKGROUP);
                  idx = (unsigned)__builtin_amdgcn_readfirstlane((int)idx);
                  if (idx >= 64u) break;
                  att::sb_wave_block(b, h, 127 - (2 * (int)idx + half), QKV, QKV + 512, QKV + 1024, YSB, lds + wave * 16384);
              }
              __syncthreads(); }
        }
    }
    SEAM(3);
    if (IN(4)) {
        pg8::Gemm g{YSB, (const bf16*)(ws + WS_WSB), T, DM, 512}; pg8::StaticOrder S; S.init(T, DM, G, bx);
        pg8::EpiBranch<true> E{H, GATES, 0};
        pg8::gemm_phase<pg8::EpiBranch<true>, pg8::StaticOrder, true, true>(lds, g, S, E);
    }
    if (IN(5)) {
        pg8::Gemm g{YFX, (const bf16*)(ws + WS_WFX), T, DM, 512}; pg8::StaticOrder S; S.init(T, DM, G, bx);
        pg8::EpiBranch<false> E{H, GATES, 1024};
        pg8::gemm_phase<pg8::EpiBranch<false>, pg8::StaticOrder, true, true>(lds, g, S, E);
    }
    SEAM(5);
#if defined(DBG_DUMP) && DBG_DUMP == 5
    dbg_dump(a, H, 1024, 0, tid, G); return;
#endif
    if (IN(6)) {
        pg8::Gemm g{H, (const bf16*)(ws + WS_WOUT), T, DM, DM}; pg8::StaticOrder S; S.init(T, DM, G, bx);
        pg8::EpiResidBf<false> E{a.in[0], nullptr, YSB, mod + 2 * DM};
        pg8::gemm_phase<pg8::EpiResidBf<false>, pg8::StaticOrder, true, true>(lds, g, S, E);
    }
    SEAM(6);
    if (IN(7)) norm_pass<1>(a, lds, tid, lane, wave, G);
    SEAM(7);
#ifndef DUP_P8
#define DUP_P8 1
#endif
    if (IN(8)) for (int rep_ = 0; rep_ < DUP_P8; ++rep_) {
        pg8::Gemm g{H, (const bf16*)(ws + WS_WGU), T, 2 * DFF, DM}; pg8::StaticOrder S; S.init(T, 2 * DFF, G, bx);
        pg8::EpiSwiglu E{ACT};
        pg8::gemm_phase<pg8::EpiSwiglu, pg8::StaticOrder, true, true>(lds, g, S, E);
    }
    SEAM(8);
    if (IN(9)) {
        pg8::Gemm g{ACT, (const bf16*)(ws + WS_WDN), T, DM, DFF}; pg8::StaticOrder S; S.init(T, DM, G, bx);
        pg8::EpiResidBf<true> E{nullptr, YSB, H, mod + 5 * DM};
        pg8::gemm_phase<pg8::EpiResidBf<true>, pg8::StaticOrder, true, true>(lds, g, S, E);
    }
    SEAM(9);
#ifdef DUP_SYNC
    for (int rep_ = 0; rep_ < DUP_SYNC; ++rep_) { asm volatile("s_waitcnt vmcnt(0) lgkmcnt(0)" ::: "memory"); __syncthreads(); grid.sync(); asm volatile("s_waitcnt vmcnt(0)" ::: "memory"); __syncthreads(); }
#endif
    if (IN(10)) norm_pass<2>(a, lds, tid, lane, wave, G);
#undef IN
#undef SEAM
}

extern "C" void kernel_launch(void* const* d_in, const int* in_sizes, int n_in, void* d_out, int out_size, void* d_ws, size_t ws_size, hipStream_t stream) {
    static int grid = 0;
    if (grid == 0) {
        if (n_in != 16 || in_sizes[0] != T * DM || out_size != T * DM || ws_size < WS_END) { fprintf(stderr, "kernel_launch: unexpected shapes (n_in %d, in0 %d, out %d, ws %zu)\n", n_in, n_in > 0 ? in_sizes[0] : -1, out_size, ws_size); grid = -1; return; }
        int dev = 0, cus = 0, per_cu = 0;
        if (hipGetDevice(&dev) != hipSuccess || hipDeviceGetAttribute(&cus, hipDeviceAttributeMultiprocessorCount, dev) != hipSuccess) { grid = -1; return; }
        if (hipFuncSetAttribute((const void*)mega_fwd, hipFuncAttributeMaxDynamicSharedMemorySize, LDS_BYTES) != hipSuccess) { fprintf(stderr, "kernel_launch: hipFuncSetAttribute failed\n"); grid = -1; return; }
        if (hipOccupancyMaxActiveBlocksPerMultiprocessor(&per_cu, (const void*)mega_fwd, 512, LDS_BYTES) != hipSuccess || per_cu < 1) { fprintf(stderr, "kernel_launch: occupancy query says %d\n", per_cu); per_cu = 1; }
        (void)hipGetLastError();
        grid = cus * per_cu;
    }
    if (grid < 0) return;
    if (hipMemsetAsync(d_ws, 0, 16384, stream) != hipSuccess) { fprintf(stderr, "kernel_launch: hipMemsetAsync failed\n"); return; }
    Args a{};
    for (int i = 0; i < 16; ++i) a.in[i] = (const float*)d_in[i];
    a.out = (float*)d_out; a.ws = (unsigned char*)d_ws;
#ifndef MK_SPLIT
#define MK_SPLIT 0
#endif
    for (int p0 = 0; p0 < NPHASE; p0 += (MK_SPLIT ? 1 : NPHASE)) {
        a.ph_lo = p0; a.ph_hi = MK_SPLIT ? p0 + 1 : NPHASE;
        void* args[] = {&a};
        const hipError_t e = hipLaunchCooperativeKernel((const void*)mega_fwd, dim3(grid), dim3(512), args, LDS_BYTES, stream);
        if (e != hipSuccess) fprintf(stderr, "kernel_launch: cooperative launch failed: %s (grid %d)\n", hipGetErrorString(e), grid);
    }
}
```

```cpp
#include <hip/hip_runtime.h>
#include <hip/hip_cooperative_groups.h>
#include <cstdio>
#include <cstdint>
namespace cg = cooperative_groups;
namespace pg8 {
#define PG8_LAS __attribute__((address_space(3)))
typedef unsigned short bf16_t;
typedef short bf16x8 __attribute__((ext_vector_type(8)));
typedef float f32x4 __attribute__((ext_vector_type(4)));
typedef unsigned u32x4 __attribute__((ext_vector_type(4)));
constexpr int BM = 256, BK = 64, HALF = 128, HTB = HALF * BK * 2  , STAGE_BYTES = 8 * HTB, NXCD = 8, WGM = 8;

__host__ __device__ __forceinline__ int lds_byte(int r, int c) { const int st = (r >> 4) * 2 + (c >> 5), rr = r & 15, cc = c & 31, ob = rr * 64 + cc * 2; return st * 1024 + (ob ^ (((ob >> 9) & 1) << 5)); }
__host__ __device__ __forceinline__ void stage_rc(int b, int& R, int& C) { const int st = b / 1024, sb = b % 1024, swz = sb ^ (((sb >> 9) & 1) << 5); R = (st >> 1) * 16 + swz / 64; C = (st & 1) * 32 + (swz % 64) / 2; }
__host__ __device__ __forceinline__ int perm32(int rho) { const int n = rho >> 4, i = rho & 15; return 8 * (i >> 2) + 4 * n + (i & 3); }

struct Unit { int pm, pn; };
struct Gemm { const bf16_t* A; const bf16_t* Bt; int M, N, K; };

struct StaticOrder {
    int nM, nN, nwg, G, c;
    __host__ __device__ void init(int M, int N, int G_, int c_) { nM = M / BM; nN = N / BM; nwg = nM * nN; G = G_; c = c_; }
    __host__ __device__ bool next(int i, Unit& u) const {
        const long L = (long)i * G + c; if (L >= nwg) return false;
        int wgid = (int)L; { const int q = nwg / NXCD, r = nwg % NXCD, xcd = wgid % NXCD, off = wgid / NXCD; wgid = (xcd < r ? xcd * (q + 1) : r * (q + 1) + (xcd - r) * q) + off; }
        const int nig = WGM * nN, gid = wgid / nig, fm = gid * WGM, gsz = (nM - fm) < WGM ? (nM - fm) : WGM;
        u.pm = fm + ((wgid % nig) % gsz); u.pn = (wgid % nig) / gsz; return true;
    }
    __device__ __forceinline__ void a_ready(const Unit&) const {}
    __device__ __forceinline__ void done(const Unit&) const {}
};

typedef float f32x2_cv __attribute__((ext_vector_type(2))); typedef __bf16 bf16x2_cv __attribute__((ext_vector_type(2)));
__device__ __forceinline__ unsigned cvt_pk_bf16(float lo, float hi) { f32x2_cv v = {lo, hi}; bf16x2_cv b = __builtin_convertvector(v, bf16x2_cv); return __builtin_bit_cast(unsigned, b); }
typedef unsigned u32x2 __attribute__((ext_vector_type(2)));
__device__ __forceinline__ float bf_lo(unsigned w) { return __uint_as_float(w << 16); }
__device__ __forceinline__ float bf_hi(unsigned w) { return __uint_as_float(w & 0xffff0000u); }
__device__ __forceinline__ float fast_sigmoid(float x) { return __builtin_amdgcn_rcpf(1.f + __builtin_amdgcn_exp2f(-1.4426950409f * x)); }
__device__ __forceinline__ u32x4 pack8(f32x4 v0, f32x4 v1) { u32x4 w; w.x = cvt_pk_bf16(v0[0], v0[1]); w.y = cvt_pk_bf16(v0[2], v0[3]); w.z = cvt_pk_bf16(v1[0], v1[1]); w.w = cvt_pk_bf16(v1[2], v1[3]); return w; }

struct EpiIn {
    static constexpr bool PERM = true, AFTER_DRAIN = false;
    bf16_t* qkv; bf16_t* gates; const float* b_gate; float qscale;
    __device__ __forceinline__ void operator()(const f32x4 (&acc)[2][2][4][2], const Unit& u, int wr, int wc, int fr, int fq) const {
        const int row0 = u.pm * BM + wr * 64 + fr;
        if (u.pn < 12) {
            const float sc = (u.pn < 2 || (u.pn >= 6 && u.pn < 8)) ? qscale : 1.f;
            const int col0 = u.pn * BM + wc * 32 + 8 * fq;
#pragma unroll
            for (int ai = 0; ai < 2; ++ai)
#pragma unroll
                for (int m = 0; m < 4; ++m) { bf16_t* rowp = qkv + (size_t)(row0 + ai * HALF + m * 16) * 3072 + col0;
#pragma unroll
                    for (int bj = 0; bj < 2; ++bj) *(u32x4*)(rowp + bj * HALF) = pack8(acc[ai][bj][m][0] * sc, acc[ai][bj][m][1] * sc); }
        } else {
            const int col0 = (u.pn - 12) * BM + wc * 32 + 8 * fq;
            f32x4 bv[2][2];
#pragma unroll
            for (int bj = 0; bj < 2; ++bj)
#pragma unroll
                for (int n = 0; n < 2; ++n) bv[bj][n] = *(const f32x4*)(b_gate + col0 + bj * HALF + 4 * n);
#pragma unroll
            for (int ai = 0; ai < 2; ++ai)
#pragma unroll
                for (int m = 0; m < 4; ++m) { bf16_t* rowp = gates + (size_t)(row0 + ai * HALF + m * 16) * 2048 + col0;
#pragma unroll
                    for (int bj = 0; bj < 2; ++bj) { f32x4 v0 = acc[ai][bj][m][0] + bv[bj][0], v1 = acc[ai][bj][m][1] + bv[bj][1];
#ifndef DBG_NOSIG
#pragma unroll
                        for (int e = 0; e < 4; ++e) { v0[e] = fast_sigmoid(v0[e]); v1[e] = fast_sigmoid(v1[e]); }
#endif
                        *(u32x4*)(rowp + bj * HALF) = pack8(v0, v1); } }
        }
    }
};
template <bool FIRST> struct EpiBranch {
    static constexpr bool PERM = true, AFTER_DRAIN = false;
    bf16_t* merged; const bf16_t* gates; int goff;
    __device__ __forceinline__ void operator()(const f32x4 (&acc)[2][2][4][2], const Unit& u, int wr, int wc, int fr, int fq) const {
        const int row0 = u.pm * BM + wr * 64 + fr, col0 = u.pn * BM + wc * 32 + 8 * fq;
#pragma unroll
        for (int ai = 0; ai < 2; ++ai)
#pragma unroll
            for (int m = 0; m < 4; ++m) { const size_t row = (size_t)(row0 + ai * HALF + m * 16);
#pragma unroll
                for (int bj = 0; bj < 2; ++bj) { const int c = col0 + bj * HALF;
                    const u32x4 gw = *(const u32x4*)(gates + row * 2048 + goff + c);
                    f32x4 g0 = {bf_lo(gw.x), bf_hi(gw.x), bf_lo(gw.y), bf_hi(gw.y)}, g1 = {bf_lo(gw.z), bf_hi(gw.z), bf_lo(gw.w), bf_hi(gw.w)};
                    f32x4 v0 = g0 * acc[ai][bj][m][0], v1 = g1 * acc[ai][bj][m][1];
                    if (!FIRST) { const u32x4 pw = *(const u32x4*)(merged + row * 1024 + c);
                        v0 += (f32x4){bf_lo(pw.x), bf_hi(pw.x), bf_lo(pw.y), bf_hi(pw.y)}; v1 += (f32x4){bf_lo(pw.z), bf_hi(pw.z), bf_lo(pw.w), bf_hi(pw.w)}; }
                    *(u32x4*)(merged + row * 1024 + c) = pack8(v0, v1); } }
    }
};
struct EpiResid {
    static constexpr bool PERM = false, AFTER_DRAIN = false;
    const float* base; float* out; const float* gate;
    __device__ __forceinline__ void operator()(const f32x4 (&acc)[2][2][4][2], const Unit& u, int wr, int wc, int fr, int fq) const {
        const int row0 = u.pm * BM + wr * 64 + fr, col0 = u.pn * BM + wc * 32 + 4 * fq, b = (u.pm * BM) >> 12;
        f32x4 gv[2][2];
#pragma unroll
        for (int bj = 0; bj < 2; ++bj)
#pragma unroll
            for (int n = 0; n < 2; ++n) gv[bj][n] = *(const f32x4*)(gate + (size_t)b * 6144 + col0 + bj * HALF + n * 16);
#pragma unroll
        for (int ai = 0; ai < 2; ++ai)
#pragma unroll
            for (int m = 0; m < 4; ++m) { const size_t off = (size_t)(row0 + ai * HALF + m * 16) * 1024 + col0;
#pragma unroll
                for (int bj = 0; bj < 2; ++bj)
#pragma unroll
                    for (int n = 0; n < 2; ++n) { const f32x4 bs = *(const f32x4*)(base + off + bj * HALF + n * 16);
                        *(f32x4*)(out + off + bj * HALF + n * 16) = bs + gv[bj][n] * acc[ai][bj][m][n]; } }
    }
};
template <bool BF_BASE> struct EpiResidBf {
    static constexpr bool PERM = true, AFTER_DRAIN = false;
    const float* basef; const bf16_t* baseb; bf16_t* out; const float* gate;
    __device__ __forceinline__ void operator()(const f32x4 (&acc)[2][2][4][2], const Unit& u, int wr, int wc, int fr, int fq) const {
        const int row0 = u.pm * BM + wr * 64 + fr, col0 = u.pn * BM + wc * 32 + 8 * fq, b = (u.pm * BM) >> 12;
        f32x4 gv[2][2];
#pragma unroll
        for (int bj = 0; bj < 2; ++bj)
#pragma unroll
            for (int n = 0; n < 2; ++n) gv[bj][n] = *(const f32x4*)(gate + (size_t)b * 6144 + col0 + bj * HALF + 4 * n);
#pragma unroll
        for (int ai = 0; ai < 2; ++ai)
#pragma unroll
            for (int m = 0; m < 4; ++m) { const size_t off = (size_t)(row0 + ai * HALF + m * 16) * 1024 + col0;
#pragma unroll
                for (int bj = 0; bj < 2; ++bj) { f32x4 v0 = gv[bj][0] * acc[ai][bj][m][0], v1 = gv[bj][1] * acc[ai][bj][m][1];
                    if (BF_BASE) { const u32x4 w = *(const u32x4*)(baseb + off + bj * HALF);
                        v0 += (f32x4){bf_lo(w.x), bf_hi(w.x), bf_lo(w.y), bf_hi(w.y)}; v1 += (f32x4){bf_lo(w.z), bf_hi(w.z), bf_lo(w.w), bf_hi(w.w)}; }
                    else { v0 += *(const f32x4*)(basef + off + bj * HALF); v1 += *(const f32x4*)(basef + off + bj * HALF + 4); }
                    *(u32x4*)(out + off + bj * HALF) = pack8(v0, v1); } }
    }
};
struct EpiSwiglu {
    static constexpr bool PERM = true, AFTER_DRAIN = false;
    bf16_t* A;
    __device__ __forceinline__ void operator()(const f32x4 (&acc)[2][2][4][2], const Unit& u, int wr, int wc, int fr, int fq) const {
        const int row0 = u.pm * BM + wr * 64 + fr, col0 = u.pn * HALF + wc * 32 + 8 * fq;
#pragma unroll
        for (int ai = 0; ai < 2; ++ai)
#pragma unroll
            for (int m = 0; m < 4; ++m) { bf16_t* rowp = A + (size_t)(row0 + ai * HALF + m * 16) * 2816 + col0;
                f32x4 r0, r1;
#pragma unroll
                for (int e = 0; e < 4; ++e) { const float g0 = acc[ai][0][m][0][e], g1 = acc[ai][0][m][1][e];
                    r0[e] = g0 * fast_sigmoid(g0) * acc[ai][1][m][0][e]; r1[e] = g1 * fast_sigmoid(g1) * acc[ai][1][m][1][e]; }
                *(u32x4*)rowp = pack8(r0, r1); }
    }
};

template <class Epi, class Sched, bool ALIGN_EPI = false, bool SP2 = false, bool MIDHOOK = false>
__device__ __forceinline__ void gemm_phase(PG8_LAS unsigned char* lds, const Gemm g, const Sched& S, const Epi& E) {
    const int tid = threadIdx.x, wid = __builtin_amdgcn_readfirstlane(tid >> 6), lane = tid & 63, wr = wid >> 2, wc = wid & 3, fr = lane & 15, fq = lane >> 4;
    const int K = g.K, nt = K / BK;
    unsigned voffA[2], voffB[2];
#pragma unroll
    for (int i = 0; i < 2; ++i) { int R, C; stage_rc(tid * 16 + i * 8192, R, C); const int Rb = Epi::PERM ? ((R & ~31) + perm32(R & 31)) : R;
        voffA[i] = (unsigned)(R * K + C) * 2u; voffB[i] = (unsigned)(Rb * K + C) * 2u; }
    const size_t kstep = (size_t)(BK * 2);
    const size_t hstep = (size_t)HALF * K * 2;
    const size_t tstep = 2 * hstep;
    const unsigned ldsw = (unsigned)wid * 1024u;
    const int aoff = lds_byte(wr * 64 + fr, fq * 8), boff = lds_byte(wc * 32 + fr, fq * 8);
#define PG8_SA(b, h) (((b) * 2 + (h)) * HTB)
#define PG8_SB(b, h) ((4 + (b) * 2 + (h)) * HTB)
#define PG8_STAGE(bufoff, gbase, voff) do { _Pragma("unroll") for (int _i = 0; _i < 2; ++_i) \
        __builtin_amdgcn_global_load_lds((const unsigned*)((const char*)(gbase) + (voff)[_i]), (PG8_LAS unsigned*)(lds + (bufoff) + ldsw + _i * 8192), 16, 0, 0); } while (0)
#define PG8_LDA(dst, b, h) do { _Pragma("unroll") for (int m = 0; m < 4; ++m) _Pragma("unroll") for (int k = 0; k < 2; ++k) dst[m][k] = *(const PG8_LAS bf16x8*)(lds + PG8_SA(b, h) + aoff + m * 2048 + k * 1024); } while (0)
#define PG8_LDB(dst, b, h) do { _Pragma("unroll") for (int n = 0; n < 2; ++n) _Pragma("unroll") for (int k = 0; k < 2; ++k) dst[n][k] = *(const PG8_LAS bf16x8*)(lds + PG8_SB(b, h) + boff + n * 2048 + k * 1024); } while (0)
#define PG8_MMA(ai, bj, At, Bt) do { __builtin_amdgcn_s_setprio(1); _Pragma("unroll") for (int m = 0; m < 4; ++m) _Pragma("unroll") for (int n = 0; n < 2; ++n) _Pragma("unroll") for (int k = 0; k < 2; ++k) \
        acc[ai][bj][m][n] = __builtin_amdgcn_mfma_f32_16x16x32_bf16(Bt[n][k], At[m][k], acc[ai][bj][m][n], 0, 0, 0); __builtin_amdgcn_s_setprio(0); } while (0)
#define PG8_WAIT_V(n) asm volatile("s_waitcnt vmcnt(" #n ")" ::: "memory")
#define PG8_WAIT_L(n) asm volatile("s_waitcnt lgkmcnt(" #n ")" ::: "memory")
#define PG8_BAR __builtin_amdgcn_s_barrier()
#define PG8_SCHED __builtin_amdgcn_sched_barrier(0)
    Unit cur, nxt; int ui = 0;
    if (!S.next(0, cur)) return;
    f32x4 acc[2][2][4][2];
#pragma unroll
    for (int a = 0; a < 2; ++a)
#pragma unroll
        for (int b = 0; b < 2; ++b)
#pragma unroll
            for (int m = 0; m < 4; ++m)
#pragma unroll
                for (int n = 0; n < 2; ++n) acc[a][b][m][n] = (f32x4){0.f, 0.f, 0.f, 0.f};
    bf16x8 At[4][2], B0[2][2], B1[2][2];
    const char* cA = (const char*)g.A + (size_t)cur.pm * tstep; const char* cB = (const char*)g.Bt + (size_t)cur.pn * tstep;
    S.a_ready(cur);
    if constexpr (SP2) {
        PG8_STAGE(PG8_SB(0, 0), cB, voffB); PG8_STAGE(PG8_SB(0, 1), cB + hstep, voffB); PG8_STAGE(PG8_SA(0, 0), cA, voffA); PG8_STAGE(PG8_SA(0, 1), cA + hstep, voffA);
        if (wr == 1) PG8_BAR;
        PG8_WAIT_V(2); PG8_BAR;
        PG8_STAGE(PG8_SB(1, 0), cB + kstep, voffB); PG8_STAGE(PG8_SA(1, 0), cA + kstep, voffA); PG8_STAGE(PG8_SB(1, 1), cB + hstep + kstep, voffB);
        PG8_WAIT_V(6); PG8_BAR;
    } else {
        PG8_STAGE(PG8_SB(0, 0), cB, voffB); PG8_STAGE(PG8_SA(0, 0), cA, voffA); PG8_STAGE(PG8_SB(0, 1), cB + hstep, voffB); PG8_STAGE(PG8_SA(0, 1), cA + hstep, voffA);
        if (wr == 1) PG8_BAR;
        PG8_WAIT_V(4); PG8_BAR;
        PG8_STAGE(PG8_SB(1, 0), cB + kstep, voffB); PG8_STAGE(PG8_SA(1, 0), cA + kstep, voffA); PG8_STAGE(PG8_SB(1, 1), cB + hstep + kstep, voffB);
        PG8_WAIT_V(6); PG8_BAR;
    }
    for (;;) {
        const bool has_next = S.next(ui + 1, nxt);
        const char* nA = has_next ? (const char*)g.A + (size_t)nxt.pm * tstep : cA; const char* nB = has_next ? (const char*)g.Bt + (size_t)nxt.pn * tstep : cB;
        for (int t = 0; t < nt; t += 2) {
            const bool last = (t == nt - 2);
            const char* a1 = cA + (size_t)(t + 1) * kstep;
            const char* a2 = last ? nA : cA + (size_t)(t + 2) * kstep; const char* b2 = last ? nB : cB + (size_t)(t + 2) * kstep;
            const char* a3 = a2 + kstep; const char* b3 = b2 + kstep;
            if (last && has_next) S.a_ready(nxt);
            if constexpr (SP2) {
            PG8_LDB(B0, 0, 0); PG8_LDB(B1, 0, 1); PG8_SCHED; PG8_LDA(At, 0, 0); PG8_STAGE(PG8_SA(1, 1), a1 + hstep, voffA);
            PG8_WAIT_V(8); PG8_WAIT_L(0); PG8_BAR; PG8_MMA(0, 0, At, B0); PG8_MMA(0, 1, At, B1); PG8_BAR; PG8_SCHED;
            PG8_LDA(At, 0, 1); PG8_STAGE(PG8_SB(0, 0), b2, voffB); PG8_STAGE(PG8_SB(0, 1), b2 + hstep, voffB); PG8_STAGE(PG8_SA(0, 0), a2, voffA);
            PG8_WAIT_V(8); PG8_WAIT_L(0); PG8_BAR; PG8_MMA(1, 0, At, B0); PG8_MMA(1, 1, At, B1); PG8_BAR; PG8_SCHED;
            PG8_LDB(B0, 1, 0); PG8_LDB(B1, 1, 1); PG8_SCHED; PG8_LDA(At, 1, 0); PG8_STAGE(PG8_SA(0, 1), a2 + hstep, voffA);
            PG8_WAIT_V(8); PG8_WAIT_L(0); PG8_BAR; PG8_MMA(0, 0, At, B0); PG8_MMA(0, 1, At, B1); PG8_BAR; PG8_SCHED;
            PG8_LDA(At, 1, 1); PG8_STAGE(PG8_SB(1, 0), b3, voffB); PG8_STAGE(PG8_SB(1, 1), b3 + hstep, voffB); PG8_STAGE(PG8_SA(1, 0), a3, voffA);
            PG8_WAIT_V(8); PG8_WAIT_L(0); PG8_BAR; PG8_MMA(1, 0, At, B0); PG8_MMA(1, 1, At, B1); PG8_BAR; PG8_SCHED;
            } else {
            PG8_LDB(B0, 0, 0); PG8_SCHED; PG8_LDA(At, 0, 0); PG8_STAGE(PG8_SA(1, 1), a1 + hstep, voffA);
            PG8_WAIT_L(8); PG8_BAR; PG8_WAIT_L(0); PG8_MMA(0, 0, At, B0); PG8_BAR; PG8_SCHED;
            PG8_LDB(B1, 0, 1); PG8_STAGE(PG8_SB(0, 0), b2, voffB);
            PG8_BAR; PG8_WAIT_L(0); PG8_MMA(0, 1, At, B1); PG8_BAR;
            PG8_LDA(At, 0, 1); PG8_STAGE(PG8_SA(0, 0), a2, voffA);
            PG8_BAR; PG8_WAIT_L(0); PG8_MMA(1, 0, At, B0); PG8_BAR; PG8_SCHED;
            PG8_STAGE(PG8_SB(0, 1), b2 + hstep, voffB);
            PG8_WAIT_V(6); PG8_BAR; PG8_MMA(1, 1, At, B1); PG8_BAR;
            PG8_LDB(B0, 1, 0); PG8_SCHED; PG8_LDA(At, 1, 0); PG8_STAGE(PG8_SA(0, 1), a2 + hstep, voffA);
            PG8_WAIT_L(8); PG8_BAR; PG8_WAIT_L(0); PG8_MMA(0, 0, At, B0); PG8_BAR; PG8_SCHED;
            PG8_LDB(B1, 1, 1); PG8_STAGE(PG8_SB(1, 0), b3, voffB);
            PG8_BAR; PG8_WAIT_L(0); PG8_MMA(0, 1, At, B1); PG8_BAR;
            PG8_LDA(At, 1, 1); PG8_STAGE(PG8_SA(1, 0), a3, voffA);
            PG8_BAR; PG8_WAIT_L(0); PG8_MMA(1, 0, At, B0); PG8_BAR; PG8_SCHED;
            PG8_STAGE(PG8_SB(1, 1), b3 + hstep, voffB);
            PG8_WAIT_V(6); PG8_BAR; PG8_MMA(1, 1, At, B1); PG8_BAR;
            }
            if constexpr (MIDHOOK) { if (t + 2 == Epi::mid_tiles) { E.mid(acc, cur, wr, wc, fr, fq); PG8_SCHED; } }
        }
        if constexpr (ALIGN_EPI) { if (wr == 0) PG8_BAR; }
        if constexpr (!Epi::AFTER_DRAIN) { E(acc, cur, wr, wc, fr, fq); S.done(cur); }
        if (!has_next) break;
#pragma unroll
        for (int a = 0; a < 2; ++a)
#pragma unroll
            for (int b = 0; b < 2; ++b)
#pragma unroll
                for (int m = 0; m < 4; ++m)
#pragma unroll
                    for (int n = 0; n < 2; ++n) acc[a][b][m][n] = (f32x4){0.f, 0.f, 0.f, 0.f};
        cur = nxt; cA = nA; cB = nB; ++ui;
        if constexpr (ALIGN_EPI) { if (wr == 1) PG8_BAR; }
    }
    PG8_WAIT_V(0);
    if constexpr (!ALIGN_EPI) { if (wr == 0) PG8_BAR; }
    PG8_BAR;
    if constexpr (Epi::AFTER_DRAIN) { E.fused(acc, cur, wr, wc, fr, fq, lds, wid, lane); S.done(cur); }
#undef PG8_SA
#undef PG8_SB
#undef PG8_STAGE
#undef PG8_LDA
#undef PG8_LDB
#undef PG8_MMA
#undef PG8_WAIT_V
#undef PG8_WAIT_L
#undef PG8_BAR
#undef PG8_SCHED
}
}

namespace att {
typedef unsigned short bf16_t;
typedef short bf16x8 __attribute__((ext_vector_type(8)));
typedef short s16x4 __attribute__((ext_vector_type(4)));
typedef float f32x16 __attribute__((ext_vector_type(16)));
typedef float f32x4 __attribute__((ext_vector_type(4)));
typedef unsigned u32x4 __attribute__((ext_vector_type(4)));
typedef unsigned u32x2 __attribute__((ext_vector_type(2)));
#define ALAS __attribute__((address_space(3)))
constexpr int SEQ = 4096, PITCH = 3072, SLOTB = 8192;
constexpr int NSLOT = 3, L_K = 0, L_V = NSLOT * SLOTB, L_CK = 2 * NSLOT * SLOTB, L_FLAG = L_CK + 16384, L_KMAX = L_FLAG + 64, L_RED = L_KMAX + 64, L_END = L_RED + 64;
constexpr float LOG2E = 1.4426950408889634f;
constexpr float FX_DONE = -152.f;
constexpr float SB_DONE = -160.f;
__device__ __forceinline__ int crow(int r, int hi) { return (r & 3) + 8 * (r >> 2) + 4 * hi; }
__device__ __forceinline__ void glds16(const void* gsrc, unsigned lds_dst) { unsigned keep;
    asm volatile("s_mov_b32 %0, m0\n\ts_mov_b32 m0, %2\n\ts_nop 0\n\tglobal_load_lds_dwordx4 %1, off\n\ts_mov_b32 m0, %0" : "=&s"(keep) : "v"(gsrc), "s"(lds_dst) : "memory"); }
typedef float f32x2_t __attribute__((ext_vector_type(2))); typedef __bf16 bf16x2_t __attribute__((ext_vector_type(2)));
__device__ __forceinline__ unsigned cvtpk(float lo, float hi) { f32x2_t v = {lo, hi}; bf16x2_t b = __builtin_convertvector(v, bf16x2_t); return __builtin_bit_cast(unsigned, b); }
typedef short v4i16_t __attribute__((ext_vector_type(4)));
__device__ __forceinline__ s16x4 vtr(const ALAS unsigned char* p) { return __builtin_bit_cast(s16x4, __builtin_amdgcn_ds_read_tr16_b64_v4i16((ALAS v4i16_t*)p)); }
#define ATT_WAIT_BAR(N) asm volatile("s_waitcnt vmcnt(" #N ") lgkmcnt(0)\n\ts_barrier" ::: "memory")
#define ATT_BAR() asm volatile("s_waitcnt lgkmcnt(0)\n\ts_barrier" ::: "memory")


__device__ __forceinline__ void fox_kmax(int b, int h, const bf16_t* K, ALAS unsigned char* shm) {
    const int tid = threadIdx.x, lane = tid & 63, wid = __builtin_amdgcn_readfirstlane(tid >> 6);
    float mx = 0.f;
    for (int r = tid; r < SEQ; r += 512) {
        const bf16_t* kr = K + ((long)b * SEQ + r) * PITCH + h * 64;
        float s = 0.f;
#pragma unroll
        for (int c = 0; c < 8; ++c) { const u32x4 w = *(const u32x4*)(kr + 8 * c);
#pragma unroll
            for (int e = 0; e < 4; ++e) { const float lo = __uint_as_float(w[e] << 16), hi = __uint_as_float(w[e] & 0xffff0000u); s += lo * lo + hi * hi; } }
        mx = fmaxf(mx, s);
    }
#pragma unroll
    for (int o = 1; o < 64; o <<= 1) mx = fmaxf(mx, __shfl_xor(mx, o));
    ALAS float* red = (ALAS float*)(shm + L_RED);
    if (lane == 0) red[wid] = mx;
    __syncthreads();
    if (tid == 0) { float m = red[0];
#pragma unroll
        for (int w = 1; w < 8; ++w) m = fmaxf(m, red[w]);
        *(ALAS float*)(shm + L_KMAX) = sqrtf(m); }
    __syncthreads();
}

template <bool SB>
__device__ __forceinline__ void attn_unit(int b, int h, int qb, const bf16_t* Q, const bf16_t* K, const bf16_t* V, const float* cum, bf16_t* O, ALAS unsigned char* shm) {
    const int tid = threadIdx.x, lane = tid & 63, r32 = lane & 31, hi = lane >> 5;
    const int wid = __builtin_amdgcn_readfirstlane(tid >> 6);
    const long rowbase = (long)b * SEQ; const int q0 = qb * 256;
    const int wq0 = q0 + wid * 32, qrow = wq0 + r32;
    const unsigned lds0 = (unsigned)(uintptr_t)shm;
    ALAS float* ck = (ALAS float*)(shm + L_CK);
    ALAS unsigned* flag = (ALAS unsigned*)(shm + L_FLAG);
    const int NT = (q0 + 256) / 64;
    const bf16_t* ksrc = K + (rowbase + lane) * PITCH + h * 64 + wid * 8;
    const bf16_t* vsrc = V + (rowbase + 16 * (wid & 3) + (lane >> 2)) * PITCH + h * 64 + (wid >> 2) * 32 + (lane & 3) * 8;
    const unsigned kdst = lds0 + L_K + wid * 1024, vdst = lds0 + L_V + wid * 1024;
#define ATT_DMA(t, so) do { glds16(ksrc + (long)(t) * 64 * PITCH, (unsigned)__builtin_amdgcn_readfirstlane(kdst + (so))); glds16(vsrc + (long)(t) * 64 * PITCH, (unsigned)__builtin_amdgcn_readfirstlane(vdst + (so))); } while (0)
    ATT_DMA(NT - 1, 0); ATT_DMA(NT - 2, SLOTB);
    bf16x8 qr[4];
    { const bf16_t* Qw = Q + (rowbase + qrow) * PITCH + h * 64 + hi * 8;
#pragma unroll
      for (int d0 = 0; d0 < 4; ++d0) qr[d0] = *(const bf16x8*)(Qw + d0 * 16); }
    float cq2 = 0.f, qkb = 0.f;
    if (!SB) {
        for (int i = tid; i < q0 + 256; i += 512) ck[i] = cum[i] * LOG2E;
        cq2 = cum[qrow] * LOG2E;
        float s = 0.f;
#pragma unroll
        for (int d0 = 0; d0 < 4; ++d0) { const u32x4 w = __builtin_bit_cast(u32x4, qr[d0]);
#pragma unroll
            for (int e = 0; e < 4; ++e) { const float lo = __uint_as_float(w[e] << 16), hh = __uint_as_float(w[e] & 0xffff0000u); s += lo * lo + hh * hh; } }
        { auto rr = __builtin_amdgcn_permlane32_swap(__float_as_uint(s), __float_as_uint(s), false, false); s = __uint_as_float(rr[0]) + __uint_as_float(rr[1]); }
        qkb = sqrtf(s) * (*(const ALAS float*)(shm + L_KMAX)) * 1.01f + 0.5f;
    }
    f32x16 o0 = {}, o1 = {};
    float mref = 0.f, l_run = 0.f, carry = SB ? 1.f : 0.f;
    bool started = false, wdone = false;
    const ALAS unsigned char* kp0 = shm + L_K + hi * 1024 + r32 * 16;
    const ALAS unsigned char* vp0 = shm + L_V + ((lane >> 4) & 1) * 32 + (lane & 3) * 8 + (4 * hi + ((lane & 15) >> 2)) * 64;
    int so = 0;
    for (int t = NT - 1; t >= 0; --t) {
        if (t > 0) { ATT_WAIT_BAR(2); } else { ATT_WAIT_BAR(0); }
        if (t < NT - 1) {
            const ALAS unsigned* fp = flag + ((t + 1) & 1) * 8;
            const u32x4 f0 = *(const ALAS u32x4*)fp, f1 = *(const ALAS u32x4*)(fp + 4);
            const unsigned all = f0.x & f0.y & f0.z & f0.w & f1.x & f1.y & f1.z & f1.w;
            if (__builtin_amdgcn_readfirstlane(all) != 0u) break;
        }
        if (t >= 2) { const int sn = (so == 0) ? 2 * SLOTB : so - SLOTB; ATT_DMA(t - 2, sn); }
        const int kv0 = 64 * t;
        if (kv0 <= wq0 + 31 && !wdone) {
            const bool needmask = (kv0 + 63 >= wq0);
            const ALAS unsigned char* kp = kp0 + so;
            f32x16 p0, p1;
            if (!SB) {
                const float base = cq2 - mref;
                const ALAS float* ckp = ck + kv0 + 4 * hi;
#pragma unroll
                for (int g = 0; g < 4; ++g) { const f32x4 c0 = *(const ALAS f32x4*)(ckp + 8 * g), c1 = *(const ALAS f32x4*)(ckp + 32 + 8 * g);
#pragma unroll
                    for (int e = 0; e < 4; ++e) { p0[4 * g + e] = base - c0[e]; p1[4 * g + e] = base - c1[e]; } }
            } else { p0 = f32x16{}; p1 = f32x16{}; }
#pragma unroll
            for (int d0 = 0; d0 < 4; ++d0) {
                const bf16x8 b0 = *(const ALAS bf16x8*)(kp + d0 * 2048), b1 = *(const ALAS bf16x8*)(kp + d0 * 2048 + 512);
                p0 = __builtin_amdgcn_mfma_f32_32x32x16_bf16(b0, qr[d0], p0, 0, 0, 0);
                p1 = __builtin_amdgcn_mfma_f32_32x32x16_bf16(b1, qr[d0], p1, 0, 0, 0);
            }
            if (!SB) {
                if (needmask) {
#pragma unroll
                    for (int r = 0; r < 16; ++r) { const int kv = kv0 + crow(r, hi); if (kv > qrow) p0[r] = -INFINITY; if (kv + 32 > qrow) p1[r] = -INFINITY; }
                }
                float mx = fmaxf(fmaxf(p0[0], p1[0]), fmaxf(p0[1], p1[1]));
#pragma unroll
                for (int r = 2; r < 16; r += 2) mx = fmaxf(fmaxf(mx, p0[r]), fmaxf(p1[r], fmaxf(p0[r + 1], p1[r + 1])));
                { auto rr = __builtin_amdgcn_permlane32_swap(__float_as_uint(mx), __float_as_uint(mx), false, false); mx = fmaxf(__uint_as_float(rr[0]), __uint_as_float(rr[1])); }
                if (__any(mx > 0.f) || !started) {
                    const float dl = started ? fmaxf(mx, 0.f) : mx;
                    mref += dl;
                    const float alpha = started ? __builtin_amdgcn_exp2f(-dl) : 0.f;
                    l_run *= alpha;
#pragma unroll
                    for (int r = 0; r < 16; ++r) { p0[r] -= dl; p1[r] -= dl; o0[r] *= alpha; o1[r] *= alpha; }
                    started = true;
                }
                float s0 = 0.f, s1 = 0.f;
#pragma unroll
                for (int r = 0; r < 16; ++r) { p0[r] = __builtin_amdgcn_exp2f(p0[r]); p1[r] = __builtin_amdgcn_exp2f(p1[r]); s0 += p0[r]; s1 += p1[r]; }
                l_run += s0 + s1;
                wdone = __all(qkb + cq2 - ck[kv0] - mref < FX_DONE);
            } else {
                f32x16 K0, K1;
#pragma unroll
                for (int r = 0; r < 16; ++r) {
                    const float e0 = __builtin_amdgcn_exp2f(fminf(p0[r], 120.f)), e1 = __builtin_amdgcn_exp2f(fminf(p1[r], 120.f));
                    float k0 = __builtin_amdgcn_rcpf(1.f + e0), k1 = __builtin_amdgcn_rcpf(1.f + e1);
                    float b0 = e0 * k0, b1 = e1 * k1;
                    if (needmask) { const int kv = kv0 + crow(r, hi); if (kv >= qrow) { k0 = 1.f; b0 = 0.f; } if (kv + 32 >= qrow) { k1 = 1.f; b1 = 0.f; } }
                    K0[r] = k0; K1[r] = k1; p0[r] = b0; p1[r] = b1;
                }
                float lo[8], hv[8];
#pragma unroll
                for (int g = 0; g < 4; ++g) {
                    const float g0 = (K0[4 * g] * K0[4 * g + 1]) * (K0[4 * g + 2] * K0[4 * g + 3]);
                    const float g1 = (K1[4 * g] * K1[4 * g + 1]) * (K1[4 * g + 2] * K1[4 * g + 3]);
                    auto r0 = __builtin_amdgcn_permlane32_swap(__float_as_uint(g0), __float_as_uint(g0), false, false);
                    auto r1 = __builtin_amdgcn_permlane32_swap(__float_as_uint(g1), __float_as_uint(g1), false, false);
                    lo[g] = __uint_as_float(r0[0]); hv[g] = __uint_as_float(r0[1]); lo[4 + g] = __uint_as_float(r1[0]); hv[4 + g] = __uint_as_float(r1[1]);
                }
                float E[8]; float R = carry;
#pragma unroll
                for (int i = 7; i >= 0; --i) { const float eh = R; R *= hv[i]; const float el = R; R *= lo[i]; E[i] = hi ? eh : el; }
                carry = R;
#pragma unroll
                for (int g = 0; g < 4; ++g) {
                    float run0 = E[g], run1 = E[4 + g];
#pragma unroll
                    for (int e = 3; e >= 0; --e) { const int r = 4 * g + e;
                        p0[r] *= run0; p1[r] *= run1; run0 *= K0[r]; run1 *= K1[r]; }
                }
                wdone = __all(carry == 0.f);
            }
            u32x4 w;
            bf16x8 pa[4];
            w = (u32x4){cvtpk(p0[0], p0[1]), cvtpk(p0[2], p0[3]), cvtpk(p0[4], p0[5]), cvtpk(p0[6], p0[7])}; pa[0] = __builtin_bit_cast(bf16x8, w);
            w = (u32x4){cvtpk(p0[8], p0[9]), cvtpk(p0[10], p0[11]), cvtpk(p0[12], p0[13]), cvtpk(p0[14], p0[15])}; pa[1] = __builtin_bit_cast(bf16x8, w);
            w = (u32x4){cvtpk(p1[0], p1[1]), cvtpk(p1[2], p1[3]), cvtpk(p1[4], p1[5]), cvtpk(p1[6], p1[7])}; pa[2] = __builtin_bit_cast(bf16x8, w);
            w = (u32x4){cvtpk(p1[8], p1[9]), cvtpk(p1[10], p1[11]), cvtpk(p1[12], p1[13]), cvtpk(p1[14], p1[15])}; pa[3] = __builtin_bit_cast(bf16x8, w);
            const ALAS unsigned char* vp = vp0 + so;
#pragma unroll
            for (int s = 0; s < 4; ++s) {
                const s16x4 a0 = vtr(vp + s * 1024), a1 = vtr(vp + s * 1024 + 512), c0 = vtr(vp + 4096 + s * 1024), c1 = vtr(vp + 4096 + s * 1024 + 512);
                const bf16x8 v0 = {a0[0], a0[1], a0[2], a0[3], a1[0], a1[1], a1[2], a1[3]}, v1 = {c0[0], c0[1], c0[2], c0[3], c1[0], c1[1], c1[2], c1[3]};
                o0 = __builtin_amdgcn_mfma_f32_32x32x16_bf16(v0, pa[s], o0, 0, 0, 0);
                o1 = __builtin_amdgcn_mfma_f32_32x32x16_bf16(v1, pa[s], o1, 0, 0, 0);
            }
        }
        if (lane == 0) flag[(t & 1) * 8 + wid] = wdone ? 1u : 0u;
        so = (so == 2 * SLOTB) ? 0 : so + SLOTB;
    }
    asm volatile("s_waitcnt vmcnt(0) lgkmcnt(0)\n\ts_barrier" ::: "memory");
    float inv = 1.f;
    if (!SB) { auto rr = __builtin_amdgcn_permlane32_swap(__float_as_uint(l_run), __float_as_uint(l_run), false, false); inv = 1.f / (__uint_as_float(rr[0]) + __uint_as_float(rr[1])); }
    bf16_t* Ow = O + (rowbase + qrow) * 512 + h * 64 + 4 * hi;
#pragma unroll
    for (int g = 0; g < 4; ++g) {
        u32x2 w0, w1;
        w0.x = cvtpk(o0[4 * g] * inv, o0[4 * g + 1] * inv); w0.y = cvtpk(o0[4 * g + 2] * inv, o0[4 * g + 3] * inv);
        w1.x = cvtpk(o1[4 * g] * inv, o1[4 * g + 1] * inv); w1.y = cvtpk(o1[4 * g + 2] * inv, o1[4 * g + 3] * inv);
        *(u32x2*)(Ow + 8 * g) = w0; *(u32x2*)(Ow + 32 + 8 * g) = w1;
    }
#undef ATT_DMA
}

constexpr int FOX_NS = 4, FL_K = 0, FL_V = FOX_NS * SLOTB, FL_CK = 2 * FOX_NS * SLOTB, FL_FLAG = FL_CK + 16384, FL_KMAX = FL_FLAG + 64, FL_RED = FL_KMAX + 64, FL_END = FL_RED + 64;
__device__ __forceinline__ void fox_kmax2(int b, int h, const bf16_t* K, ALAS unsigned char* shm) {
    const int tid = threadIdx.x, lane = tid & 63, wid = __builtin_amdgcn_readfirstlane(tid >> 6);
    float mx = 0.f;
    for (int r = tid; r < SEQ; r += 512) {
        const bf16_t* kr = K + ((long)b * SEQ + r) * PITCH + h * 64;
        float s = 0.f;
#pragma unroll
        for (int c = 0; c < 8; ++c) { const u32x4 w = *(const u32x4*)(kr + 8 * c);
#pragma unroll
            for (int e = 0; e < 4; ++e) { const float lo = __uint_as_float(w[e] << 16), hi = __uint_as_float(w[e] & 0xffff0000u); s += lo * lo + hi * hi; } }
        mx = fmaxf(mx, s);
    }
#pragma unroll
    for (int o = 1; o < 64; o <<= 1) mx = fmaxf(mx, __shfl_xor(mx, o));
    ALAS float* red = (ALAS float*)(shm + FL_RED);
    __syncthreads();
    if (lane == 0) red[wid] = mx;
    __syncthreads();
    if (tid == 0) { float m = red[0];
#pragma unroll
        for (int w = 1; w < 8; ++w) m = fmaxf(m, red[w]);
        *(ALAS float*)(shm + FL_KMAX) = sqrtf(m); }
    __syncthreads();
}
__device__ __forceinline__ void fox_unit(int b, int h, int qb, const bf16_t* Q, const bf16_t* K, const bf16_t* V, const float* cum, bf16_t* O, ALAS unsigned char* shm) {
    const int tid = threadIdx.x, lane = tid & 63, r32 = lane & 31, hi = lane >> 5;
    const int wid = __builtin_amdgcn_readfirstlane(tid >> 6);
    const long rowbase = (long)b * SEQ; const int q0 = qb * 256;
    const int wq0 = q0 + wid * 32, qrow = wq0 + r32;
    const unsigned lds0 = (unsigned)(uintptr_t)shm;
    ALAS float* ck = (ALAS float*)(shm + FL_CK);
    ALAS unsigned* flag = (ALAS unsigned*)(shm + FL_FLAG);
    const int NT = (q0 + 256) / 64;
    const bf16_t* ksrc = K + (rowbase + lane) * PITCH + h * 64 + wid * 8;
    const bf16_t* vsrc = V + (rowbase + 16 * (wid & 3) + (lane >> 2)) * PITCH + h * 64 + (wid >> 2) * 32 + (lane & 3) * 8;
    const unsigned kdst = lds0 + FL_K + wid * 1024, vdst = lds0 + FL_V + wid * 1024;
#define FOX_DMA(t, so) do { glds16(ksrc + (long)(t) * 64 * PITCH, (unsigned)__builtin_amdgcn_readfirstlane(kdst + (so))); glds16(vsrc + (long)(t) * 64 * PITCH, (unsigned)__builtin_amdgcn_readfirstlane(vdst + (so))); } while (0)
    FOX_DMA(NT - 1, 0); FOX_DMA(NT - 2, SLOTB); FOX_DMA(NT - 3, 2 * SLOTB);
    bf16x8 qr[4];
    { const bf16_t* Qw = Q + (rowbase + qrow) * PITCH + h * 64 + hi * 8;
#pragma unroll
      for (int d0 = 0; d0 < 4; ++d0) qr[d0] = *(const bf16x8*)(Qw + d0 * 16); }
    for (int i = tid; i < q0 + 256; i += 512) ck[i] = cum[i] * LOG2E;
    const float cq2 = cum[qrow] * LOG2E;
    float qkb;
    { float s = 0.f;
#pragma unroll
      for (int d0 = 0; d0 < 4; ++d0) { const u32x4 w = __builtin_bit_cast(u32x4, qr[d0]);
#pragma unroll
          for (int e = 0; e < 4; ++e) { const float lo = __uint_as_float(w[e] << 16), hh = __uint_as_float(w[e] & 0xffff0000u); s += lo * lo + hh * hh; } }
      { auto rr = __builtin_amdgcn_permlane32_swap(__float_as_uint(s), __float_as_uint(s), false, false); s = __uint_as_float(rr[0]) + __uint_as_float(rr[1]); }
      qkb = sqrtf(s) * (*(const ALAS float*)(shm + FL_KMAX)) * 1.01f + 0.5f; }
    f32x16 o0 = {}, o1 = {};
    f32x16 sC0 = {}, sC1 = {}, sN0 = {}, sN1 = {};
    float mref = 0.f, sref = 0.f, srefN = 0.f, l_run = 0.f;
    bool started = false, wdone = false;
    const ALAS unsigned char* kp0 = shm + FL_K + hi * 1024 + r32 * 16;
    const ALAS unsigned char* vp0 = shm + FL_V + ((lane >> 4) & 1) * 32 + (lane & 3) * 8 + (4 * hi + ((lane & 15) >> 2)) * 64;
#define FOX_QK(D0, D1, tt, so_, ref_) do { const float base_ = cq2 - (ref_); const ALAS float* ckp_ = ck + 64 * (tt) + 4 * hi; \
        _Pragma("unroll") for (int g = 0; g < 4; ++g) { const f32x4 c0_ = *(const ALAS f32x4*)(ckp_ + 8 * g), c1_ = *(const ALAS f32x4*)(ckp_ + 32 + 8 * g); \
            _Pragma("unroll") for (int e = 0; e < 4; ++e) { D0[4 * g + e] = base_ - c0_[e]; D1[4 * g + e] = base_ - c1_[e]; } } \
        const ALAS unsigned char* kp_ = kp0 + (so_); \
        _Pragma("unroll") for (int d0 = 0; d0 < 4; ++d0) { const bf16x8 b0_ = *(const ALAS bf16x8*)(kp_ + d0 * 2048), b1_ = *(const ALAS bf16x8*)(kp_ + d0 * 2048 + 512); \
            D0 = __builtin_amdgcn_mfma_f32_32x32x16_bf16(b0_, qr[d0], D0, 0, 0, 0); D1 = __builtin_amdgcn_mfma_f32_32x32x16_bf16(b1_, qr[d0], D1, 0, 0, 0); } } while (0)
    ATT_WAIT_BAR(4);
    if (64 * (NT - 1) <= wq0 + 31) { FOX_QK(sC0, sC1, NT - 1, 0, 0.f); }
    int so = 0;
    for (int t = NT - 1; t >= 0; --t) {
        if (t >= 2) { ATT_WAIT_BAR(3); } else if (t == 1) { ATT_WAIT_BAR(1); } else { ATT_WAIT_BAR(0); }
        if (t < NT - 1) {
            const ALAS unsigned* fp = flag + ((t + 1) & 1) * 8;
            const u32x4 f0 = *(const ALAS u32x4*)fp, f1 = *(const ALAS u32x4*)(fp + 4);
            const unsigned all = f0.x & f0.y & f0.z & f0.w & f1.x & f1.y & f1.z & f1.w;
            if (__builtin_amdgcn_readfirstlane(all) != 0u) break;
        }
        const int so1 = (so == (FOX_NS - 1) * SLOTB) ? 0 : so + SLOTB;
        if (t >= 3) { const int sp = (so == 0) ? (FOX_NS - 1) * SLOTB : so - SLOTB; FOX_DMA(t - 3, sp); }
        const bool actN = (t >= 1) && (64 * (t - 1) <= wq0 + 31) && !wdone;
        const bool actC = (64 * t <= wq0 + 31) && !wdone;
        if (actN) { FOX_QK(sN0, sN1, t - 1, so1, mref); srefN = mref; }
        if (actC) {
            const int kv0 = 64 * t;
            if (kv0 + 63 >= wq0) {
#pragma unroll
                for (int r = 0; r < 16; ++r) { const int kv = kv0 + crow(r, hi); if (kv > qrow) sC0[r] = -INFINITY; if (kv + 32 > qrow) sC1[r] = -INFINITY; }
            }
            float mx = fmaxf(fmaxf(sC0[0], sC1[0]), fmaxf(sC0[1], sC1[1]));
#pragma unroll
            for (int r = 2; r < 16; r += 2) mx = fmaxf(fmaxf(mx, sC0[r]), fmaxf(sC1[r], fmaxf(sC0[r + 1], sC1[r + 1])));
            { auto rr = __builtin_amdgcn_permlane32_swap(__float_as_uint(mx), __float_as_uint(mx), false, false); mx = fmaxf(__uint_as_float(rr[0]), __uint_as_float(rr[1])); }
            const float mt = mx + sref;
            const float mnew = started ? fmaxf(mref, mt) : mt;
            const float adj = sref - mnew;
            if (__any(adj != 0.f) || !started) {
                const float alpha = started ? __builtin_amdgcn_exp2f(mref - mnew) : 0.f;
                l_run *= alpha;
#pragma unroll
                for (int r = 0; r < 16; ++r) { sC0[r] += adj; sC1[r] += adj; o0[r] *= alpha; o1[r] *= alpha; }
                started = true;
            }
            mref = mnew;
            float s0 = 0.f, s1 = 0.f;
#pragma unroll
            for (int r = 0; r < 16; ++r) { sC0[r] = __builtin_amdgcn_exp2f(sC0[r]); sC1[r] = __builtin_amdgcn_exp2f(sC1[r]); s0 += sC0[r]; s1 += sC1[r]; }
            l_run += s0 + s1;
            u32x4 w; bf16x8 pa[4];
            w = (u32x4){cvtpk(sC0[0], sC0[1]), cvtpk(sC0[2], sC0[3]), cvtpk(sC0[4], sC0[5]), cvtpk(sC0[6], sC0[7])}; pa[0] = __builtin_bit_cast(bf16x8, w);
            w = (u32x4){cvtpk(sC0[8], sC0[9]), cvtpk(sC0[10], sC0[11]), cvtpk(sC0[12], sC0[13]), cvtpk(sC0[14], sC0[15])}; pa[1] = __builtin_bit_cast(bf16x8, w);
            w = (u32x4){cvtpk(sC1[0], sC1[1]), cvtpk(sC1[2], sC1[3]), cvtpk(sC1[4], sC1[5]), cvtpk(sC1[6], sC1[7])}; pa[2] = __builtin_bit_cast(bf16x8, w);
            w = (u32x4){cvtpk(sC1[8], sC1[9]), cvtpk(sC1[10], sC1[11]), cvtpk(sC1[12], sC1[13]), cvtpk(sC1[14], sC1[15])}; pa[3] = __builtin_bit_cast(bf16x8, w);
            const ALAS unsigned char* vp = vp0 + so;
#pragma unroll
            for (int s = 0; s < 4; ++s) {
                const s16x4 a0 = vtr(vp + s * 1024), a1 = vtr(vp + s * 1024 + 512), c0 = vtr(vp + 4096 + s * 1024), c1 = vtr(vp + 4096 + s * 1024 + 512);
                const bf16x8 v0 = {a0[0], a0[1], a0[2], a0[3], a1[0], a1[1], a1[2], a1[3]}, v1 = {c0[0], c0[1], c0[2], c0[3], c1[0], c1[1], c1[2], c1[3]};
                o0 = __builtin_amdgcn_mfma_f32_32x32x16_bf16(v0, pa[s], o0, 0, 0, 0);
                o1 = __builtin_amdgcn_mfma_f32_32x32x16_bf16(v1, pa[s], o1, 0, 0, 0);
            }
            wdone = __all(qkb + cq2 - ck[kv0] - mref < FX_DONE);
        }
        sC0 = sN0; sC1 = sN1; sref = srefN;
        if (lane == 0) flag[(t & 1) * 8 + wid] = wdone ? 1u : 0u;
        so = so1;
    }
    asm volatile("s_waitcnt vmcnt(0) lgkmcnt(0)\n\ts_barrier" ::: "memory");
    float inv;
    { auto rr = __builtin_amdgcn_permlane32_swap(__float_as_uint(l_run), __float_as_uint(l_run), false, false); inv = 1.f / (__uint_as_float(rr[0]) + __uint_as_float(rr[1])); }
    bf16_t* Ow = O + (rowbase + qrow) * 512 + h * 64 + 4 * hi;
#pragma unroll
    for (int g = 0; g < 4; ++g) {
        u32x2 w0, w1;
        w0.x = cvtpk(o0[4 * g] * inv, o0[4 * g + 1] * inv); w0.y = cvtpk(o0[4 * g + 2] * inv, o0[4 * g + 3] * inv);
        w1.x = cvtpk(o1[4 * g] * inv, o1[4 * g + 1] * inv); w1.y = cvtpk(o1[4 * g + 2] * inv, o1[4 * g + 3] * inv);
        *(u32x2*)(Ow + 8 * g) = w0; *(u32x2*)(Ow + 32 + 8 * g) = w1;
    }
#undef FOX_DMA
#undef FOX_QK
}

__device__ __forceinline__ void fox_unit64(int b, int h, int qb, const bf16_t* Q, const bf16_t* K, const bf16_t* V, const float* cum, bf16_t* O, ALAS unsigned char* shm) {
    const int tid = threadIdx.x, lane = tid & 63, r32 = lane & 31, hi = lane >> 5;
    const int wid = __builtin_amdgcn_readfirstlane(tid >> 6);
    const long rowbase = (long)b * SEQ; const int q0 = qb * 512;
    const int wq0 = q0 + wid * 64;
    const unsigned lds0 = (unsigned)(uintptr_t)shm;
    ALAS float* ck = (ALAS float*)(shm + L_CK);
    ALAS unsigned* flag = (ALAS unsigned*)(shm + L_FLAG);
    const int NT = (q0 + 512) / 64;
    const bf16_t* ksrc = K + (rowbase + lane) * PITCH + h * 64 + wid * 8;
    const bf16_t* vsrc = V + (rowbase + 16 * (wid & 3) + (lane >> 2)) * PITCH + h * 64 + (wid >> 2) * 32 + (lane & 3) * 8;
    const unsigned kdst = lds0 + L_K + wid * 1024, vdst = lds0 + L_V + wid * 1024;
#define ATT_DMA(t, so) do { glds16(ksrc + (long)(t) * 64 * PITCH, (unsigned)__builtin_amdgcn_readfirstlane(kdst + (so))); glds16(vsrc + (long)(t) * 64 * PITCH, (unsigned)__builtin_amdgcn_readfirstlane(vdst + (so))); } while (0)
    ATT_DMA(NT - 1, 0); ATT_DMA(NT - 2, SLOTB);
    bf16x8 qr[2][4]; float cq2[2], qkb[2];
    for (int i = tid; i < q0 + 512; i += 512) ck[i] = cum[i] * LOG2E;
    const float kmx = *(const ALAS float*)(shm + L_KMAX);
#pragma unroll
    for (int hh = 0; hh < 2; ++hh) {
        const int qrow = wq0 + 32 * hh + r32;
        const bf16_t* Qw = Q + (rowbase + qrow) * PITCH + h * 64 + hi * 8;
#pragma unroll
        for (int d0 = 0; d0 < 4; ++d0) qr[hh][d0] = *(const bf16x8*)(Qw + d0 * 16);
        cq2[hh] = cum[qrow] * LOG2E;
        float s = 0.f;
#pragma unroll
        for (int d0 = 0; d0 < 4; ++d0) { const u32x4 w = __builtin_bit_cast(u32x4, qr[hh][d0]);
#pragma unroll
            for (int e = 0; e < 4; ++e) { const float lo = __uint_as_float(w[e] << 16), hv = __uint_as_float(w[e] & 0xffff0000u); s += lo * lo + hv * hv; } }
        { auto rr = __builtin_amdgcn_permlane32_swap(__float_as_uint(s), __float_as_uint(s), false, false); s = __uint_as_float(rr[0]) + __uint_as_float(rr[1]); }
        qkb[hh] = sqrtf(s) * kmx * 1.01f + 0.5f;
    }
    f32x16 o[2][2] = {};
    float mref[2] = {0.f, 0.f}, l_run[2] = {0.f, 0.f};
    bool started[2] = {false, false}; bool wdone = false;
    const ALAS unsigned char* kp0 = shm + L_K + hi * 1024 + r32 * 16;
    const ALAS unsigned char* vp0 = shm + L_V + ((lane >> 4) & 1) * 32 + (lane & 3) * 8 + (4 * hi + ((lane & 15) >> 2)) * 64;
    int so = 0;
    for (int t = NT - 1; t >= 0; --t) {
        if (t > 0) { ATT_WAIT_BAR(2); } else { ATT_WAIT_BAR(0); }
        if (t < NT - 1) {
            const ALAS unsigned* fp = flag + ((t + 1) & 1) * 8;
            const u32x4 f0 = *(const ALAS u32x4*)fp, f1 = *(const ALAS u32x4*)(fp + 4);
            const unsigned all = f0.x & f0.y & f0.z & f0.w & f1.x & f1.y & f1.z & f1.w;
            if (__builtin_amdgcn_readfirstlane(all) != 0u) break;
        }
        if (t >= 2) { const int sn = (so == 0) ? 2 * SLOTB : so - SLOTB; ATT_DMA(t - 2, sn); }
        const int kv0 = 64 * t;
        if (kv0 <= wq0 + 63 && !wdone) {
            const bool both = (kv0 <= wq0 + 31);
            const ALAS unsigned char* kp = kp0 + so;
            f32x16 p[2][2];
            { const ALAS float* ckp = ck + kv0 + 4 * hi;
              const float base1 = cq2[1] - mref[1], base0 = cq2[0] - mref[0];
#pragma unroll
              for (int g = 0; g < 4; ++g) { const f32x4 c0 = *(const ALAS f32x4*)(ckp + 8 * g), c1 = *(const ALAS f32x4*)(ckp + 32 + 8 * g);
#pragma unroll
                  for (int e = 0; e < 4; ++e) { p[1][0][4 * g + e] = base1 - c0[e]; p[1][1][4 * g + e] = base1 - c1[e]; p[0][0][4 * g + e] = base0 - c0[e]; p[0][1][4 * g + e] = base0 - c1[e]; } } }
            __builtin_amdgcn_sched_barrier(0);
#pragma unroll
            for (int d0 = 0; d0 < 4; ++d0) {
                const bf16x8 b0 = *(const ALAS bf16x8*)(kp + d0 * 2048), b1 = *(const ALAS bf16x8*)(kp + d0 * 2048 + 512);
                p[1][0] = __builtin_amdgcn_mfma_f32_32x32x16_bf16(b0, qr[1][d0], p[1][0], 0, 0, 0);
                p[1][1] = __builtin_amdgcn_mfma_f32_32x32x16_bf16(b1, qr[1][d0], p[1][1], 0, 0, 0);
                if (both) { p[0][0] = __builtin_amdgcn_mfma_f32_32x32x16_bf16(b0, qr[0][d0], p[0][0], 0, 0, 0);
                            p[0][1] = __builtin_amdgcn_mfma_f32_32x32x16_bf16(b1, qr[0][d0], p[0][1], 0, 0, 0); }
            }
            __builtin_amdgcn_sched_barrier(0);
            bf16x8 pa[2][4];
            bool done2 = true;
#pragma unroll
            for (int hh = 1; hh >= 0; --hh) if (hh == 1 || both) {
                const int hq0 = wq0 + 32 * hh, qrow = hq0 + r32;
                if (kv0 + 63 >= hq0) {
#pragma unroll
                    for (int r = 0; r < 16; ++r) { const int kv = kv0 + crow(r, hi); if (kv > qrow) p[hh][0][r] = -INFINITY; if (kv + 32 > qrow) p[hh][1][r] = -INFINITY; }
                }
                float mx = fmaxf(fmaxf(p[hh][0][0], p[hh][1][0]), fmaxf(p[hh][0][1], p[hh][1][1]));
#pragma unroll
                for (int r = 2; r < 16; r += 2) mx = fmaxf(fmaxf(mx, p[hh][0][r]), fmaxf(p[hh][1][r], fmaxf(p[hh][0][r + 1], p[hh][1][r + 1])));
                { auto rr = __builtin_amdgcn_permlane32_swap(__float_as_uint(mx), __float_as_uint(mx), false, false); mx = fmaxf(__uint_as_float(rr[0]), __uint_as_float(rr[1])); }
                if (__any(mx > 0.f) || !started[hh]) {
                    const float dl = started[hh] ? fmaxf(mx, 0.f) : mx;
                    mref[hh] += dl;
                    const float alpha = started[hh] ? __builtin_amdgcn_exp2f(-dl) : 0.f;
                    l_run[hh] *= alpha;
#pragma unroll
                    for (int r = 0; r < 16; ++r) { p[hh][0][r] -= dl; p[hh][1][r] -= dl; o[hh][0][r] *= alpha; o[hh][1][r] *= alpha; }
                    started[hh] = true;
                }
                float s0 = 0.f, s1 = 0.f;
#pragma unroll
                for (int r = 0; r < 16; ++r) { p[hh][0][r] = __builtin_amdgcn_exp2f(p[hh][0][r]); p[hh][1][r] = __builtin_amdgcn_exp2f(p[hh][1][r]); s0 += p[hh][0][r]; s1 += p[hh][1][r]; }
                l_run[hh] += s0 + s1;
                u32x4 w;
                w = (u32x4){cvtpk(p[hh][0][0], p[hh][0][1]), cvtpk(p[hh][0][2], p[hh][0][3]), cvtpk(p[hh][0][4], p[hh][0][5]), cvtpk(p[hh][0][6], p[hh][0][7])}; pa[hh][0] = __builtin_bit_cast(bf16x8, w);
                w = (u32x4){cvtpk(p[hh][0][8], p[hh][0][9]), cvtpk(p[hh][0][10], p[hh][0][11]), cvtpk(p[hh][0][12], p[hh][0][13]), cvtpk(p[hh][0][14], p[hh][0][15])}; pa[hh][1] = __builtin_bit_cast(bf16x8, w);
                w = (u32x4){cvtpk(p[hh][1][0], p[hh][1][1]), cvtpk(p[hh][1][2], p[hh][1][3]), cvtpk(p[hh][1][4], p[hh][1][5]), cvtpk(p[hh][1][6], p[hh][1][7])}; pa[hh][2] = __builtin_bit_cast(bf16x8, w);
                w = (u32x4){cvtpk(p[hh][1][8], p[hh][1][9]), cvtpk(p[hh][1][10], p[hh][1][11]), cvtpk(p[hh][1][12], p[hh][1][13]), cvtpk(p[hh][1][14], p[hh][1][15])}; pa[hh][3] = __builtin_bit_cast(bf16x8, w);
                done2 = done2 && __all(qkb[hh] + cq2[hh] - ck[kv0] - mref[hh] < FX_DONE);
            } else { done2 = false; }
            const ALAS unsigned char* vp = vp0 + so;
#pragma unroll
            for (int s = 0; s < 4; ++s) {
                const s16x4 a0 = vtr(vp + s * 1024), a1 = vtr(vp + s * 1024 + 512), c0 = vtr(vp + 4096 + s * 1024), c1 = vtr(vp + 4096 + s * 1024 + 512);
                const bf16x8 v0 = {a0[0], a0[1], a0[2], a0[3], a1[0], a1[1], a1[2], a1[3]}, v1 = {c0[0], c0[1], c0[2], c0[3], c1[0], c1[1], c1[2], c1[3]};
                o[1][0] = __builtin_amdgcn_mfma_f32_32x32x16_bf16(v0, pa[1][s], o[1][0], 0, 0, 0);
                o[1][1] = __builtin_amdgcn_mfma_f32_32x32x16_bf16(v1, pa[1][s], o[1][1], 0, 0, 0);
                if (both) { o[0][0] = __builtin_amdgcn_mfma_f32_32x32x16_bf16(v0, pa[0][s], o[0][0], 0, 0, 0);
                            o[0][1] = __builtin_amdgcn_mfma_f32_32x32x16_bf16(v1, pa[0][s], o[0][1], 0, 0, 0); }
            }
            wdone = done2;
        }
        if (lane == 0) flag[(t & 1) * 8 + wid] = wdone ? 1u : 0u;
        so = (so == 2 * SLOTB) ? 0 : so + SLOTB;
    }
    asm volatile("s_waitcnt vmcnt(0) lgkmcnt(0)\n\ts_barrier" ::: "memory");
#pragma unroll
    for (int hh = 0; hh < 2; ++hh) {
        float inv; { auto rr = __builtin_amdgcn_permlane32_swap(__float_as_uint(l_run[hh]), __float_as_uint(l_run[hh]), false, false); inv = 1.f / (__uint_as_float(rr[0]) + __uint_as_float(rr[1])); }
        bf16_t* Ow = O + (rowbase + wq0 + 32 * hh + r32) * 512 + h * 64 + 4 * hi;
#pragma unroll
        for (int g = 0; g < 4; ++g) {
            u32x2 w0, w1;
            w0.x = cvtpk(o[hh][0][4 * g] * inv, o[hh][0][4 * g + 1] * inv); w0.y = cvtpk(o[hh][0][4 * g + 2] * inv, o[hh][0][4 * g + 3] * inv);
            w1.x = cvtpk(o[hh][1][4 * g] * inv, o[hh][1][4 * g + 1] * inv); w1.y = cvtpk(o[hh][1][4 * g + 2] * inv, o[hh][1][4 * g + 3] * inv);
            *(u32x2*)(Ow + 8 * g) = w0; *(u32x2*)(Ow + 32 + 8 * g) = w1;
        }
    }
#undef ATT_DMA
}

__device__ __forceinline__ void sb_wave_block(int b, int h, int j, const bf16_t* Q, const bf16_t* K, const bf16_t* V, bf16_t* O, ALAS unsigned char* wl) {
    const int lane = threadIdx.x & 63, r32 = lane & 31, hi = lane >> 5;
    const long rowbase = (long)b * SEQ; const int qrow = 32 * j + r32;
    const unsigned l0 = (unsigned)(uintptr_t)wl;
    const bf16_t* ksrc = K + (rowbase + (lane & 31)) * PITCH + h * 64 + (lane >> 5) * 8;
    const bf16_t* vsrc = V + (rowbase + (lane >> 2)) * PITCH + h * 64 + (lane & 3) * 8;
#define SBW_DMA(tt, bo) do { const long ro_ = (long)(tt) * 32 * PITCH; \
        _Pragma("unroll") for (int c_ = 0; c_ < 4; ++c_) glds16(ksrc + ro_ + c_ * 16, (unsigned)__builtin_amdgcn_readfirstlane(l0 + (bo) + c_ * 1024)); \
        _Pragma("unroll") for (int p_ = 0; p_ < 4; ++p_) glds16(vsrc + ro_ + (long)(16 * (p_ & 1)) * PITCH + (p_ >> 1) * 32, (unsigned)__builtin_amdgcn_readfirstlane(l0 + (bo) + 4096 + p_ * 1024)); } while (0)
    SBW_DMA(j, 0);
    bf16x8 qr[4];
    { const bf16_t* Qw = Q + (rowbase + qrow) * PITCH + h * 64 + hi * 8;
#pragma unroll
      for (int d0 = 0; d0 < 4; ++d0) qr[d0] = *(const bf16x8*)(Qw + d0 * 16); }
    f32x16 o0 = {}, o1 = {};
    float carry = 1.f;
    const ALAS unsigned char* kp0 = wl + hi * 512 + r32 * 16;
    const ALAS unsigned char* vp0 = wl + 4096 + ((lane >> 4) & 1) * 32 + (lane & 3) * 8 + (4 * hi + ((lane & 15) >> 2)) * 64;
    int bo = 0;
    for (int tt = j; tt >= 0; --tt) {
        asm volatile("s_waitcnt lgkmcnt(0)" ::: "memory");
        if (tt > 0) { SBW_DMA(tt - 1, bo ^ 8192); asm volatile("s_waitcnt vmcnt(8)" ::: "memory"); } else { asm volatile("s_waitcnt vmcnt(0)" ::: "memory"); }
        const int kv0 = 32 * tt;
        const ALAS unsigned char* kp = kp0 + bo;
        f32x16 p0 = {};
#pragma unroll
        for (int d0 = 0; d0 < 4; ++d0) { const bf16x8 kf = *(const ALAS bf16x8*)(kp + d0 * 1024); p0 = __builtin_amdgcn_mfma_f32_32x32x16_bf16(kf, qr[d0], p0, 0, 0, 0); }
        const bool diag = (tt == j);
        f32x16 K0;
#pragma unroll
        for (int r = 0; r < 16; ++r) {
            const float e0 = __builtin_amdgcn_exp2f(fminf(p0[r], 120.f));
            float k0 = __builtin_amdgcn_rcpf(1.f + e0), b0 = e0 * k0;
            if (diag) { const int kv = kv0 + crow(r, hi); if (kv >= qrow) { k0 = 1.f; b0 = 0.f; } }
            K0[r] = k0; p0[r] = b0;
        }
        float lo[4], hv[4];
#pragma unroll
        for (int g = 0; g < 4; ++g) { const float g0 = (K0[4 * g] * K0[4 * g + 1]) * (K0[4 * g + 2] * K0[4 * g + 3]);
            auto r0 = __builtin_amdgcn_permlane32_swap(__float_as_uint(g0), __float_as_uint(g0), false, false);
            lo[g] = __uint_as_float(r0[0]); hv[g] = __uint_as_float(r0[1]); }
        float E[4]; float R = carry;
#pragma unroll
        for (int i = 3; i >= 0; --i) { const float eh = R; R *= hv[i]; const float el = R; R *= lo[i]; E[i] = hi ? eh : el; }
        carry = R;
#pragma unroll
        for (int g = 0; g < 4; ++g) { float run0 = E[g];
#pragma unroll
            for (int e = 3; e >= 0; --e) { const int r = 4 * g + e; p0[r] *= run0; run0 *= K0[r]; } }
        u32x4 w; bf16x8 pa[2];
        w = (u32x4){cvtpk(p0[0], p0[1]), cvtpk(p0[2], p0[3]), cvtpk(p0[4], p0[5]), cvtpk(p0[6], p0[7])}; pa[0] = __builtin_bit_cast(bf16x8, w);
        w = (u32x4){cvtpk(p0[8], p0[9]), cvtpk(p0[10], p0[11]), cvtpk(p0[12], p0[13]), cvtpk(p0[14], p0[15])}; pa[1] = __builtin_bit_cast(bf16x8, w);
        const ALAS unsigned char* vp = vp0 + bo;
#pragma unroll
        for (int s = 0; s < 2; ++s) {
            const s16x4 a0 = vtr(vp + s * 1024), a1 = vtr(vp + s * 1024 + 512), c0 = vtr(vp + 2048 + s * 1024), c1 = vtr(vp + 2048 + s * 1024 + 512);
            const bf16x8 v0 = {a0[0], a0[1], a0[2], a0[3], a1[0], a1[1], a1[2], a1[3]}, v1 = {c0[0], c0[1], c0[2], c0[3], c1[0], c1[1], c1[2], c1[3]};
            o0 = __builtin_amdgcn_mfma_f32_32x32x16_bf16(v0, pa[s], o0, 0, 0, 0);
            o1 = __builtin_amdgcn_mfma_f32_32x32x16_bf16(v1, pa[s], o1, 0, 0, 0);
        }
        bo ^= 8192;
        if (__all(carry == 0.f)) break;
    }
    asm volatile("s_waitcnt vmcnt(0) lgkmcnt(0)" ::: "memory");
    bf16_t* Ow = O + (rowbase + qrow) * 512 + h * 64 + 4 * hi;
#pragma unroll
    for (int g = 0; g < 4; ++g) {
        u32x2 w0, w1;
        w0.x = cvtpk(o0[4 * g], o0[4 * g + 1]); w0.y = cvtpk(o0[4 * g + 2], o0[4 * g + 3]);
        w1.x = cvtpk(o1[4 * g], o1[4 * g + 1]); w1.y = cvtpk(o1[4 * g + 2], o1[4 * g + 3]);
        *(u32x2*)(Ow + 8 * g) = w0; *(u32x2*)(Ow + 32 + 8 * g) = w1;
    }
#undef SBW_DMA
}
}


#define LAS __attribute__((address_space(3)))
typedef unsigned short bf16;
typedef float f32x4 __attribute__((ext_vector_type(4)));
typedef unsigned u32x4v __attribute__((ext_vector_type(4)));
typedef unsigned u32x2v __attribute__((ext_vector_type(2)));
constexpr int NB = 16, SEQ = 4096, DM = 1024, T = NB * SEQ, DFF = 2816, DINP = 5128, NIN = 5120, NMOD = 6144;
constexpr float RMS_EPS = 1e-6f;
constexpr float QSCALE = 0.125f * 1.4426950408889634f;
constexpr size_t MiB = 1u << 20;
constexpr size_t WS_MOD = 1 * MiB, WS_LOGF = 2 * MiB, WS_CUM = 4 * MiB, WS_WIN = 8 * MiB, WS_WSB = 18 * MiB, WS_WFX = 19 * MiB, WS_WOUT = 20 * MiB, WS_WGU = 22 * MiB, WS_WDN = 34 * MiB;
constexpr size_t WS_H = 64 * MiB, WS_YSB = 192 * MiB, WS_YFX = 256 * MiB, WS_GATES = 320 * MiB, WS_QKV = 576 * MiB, WS_ACT = 576 * MiB, WS_END = 960 * MiB;
constexpr int LDS_BYTES = 147456;
constexpr int NPHASE = 11;

struct Args { const float* in[16]; float* out; unsigned char* ws; int ph_lo, ph_hi; };

__device__ __forceinline__ float wave_sum(float v) {
#pragma unroll
    for (int o = 1; o < 64; o <<= 1) v += __shfl_xor(v, o);
    return v;
}
__device__ __forceinline__ unsigned f2bf(float f) { unsigned u = __builtin_bit_cast(unsigned, f); return (u + 0x7fffu + ((u >> 16) & 1u)) >> 16; }
__device__ __forceinline__ unsigned pk2(float lo, float hi) { return f2bf(lo) | (f2bf(hi) << 16); }

__device__ __forceinline__ void transpose_item(const float* W, int ldw, int K, int src_col0, bf16* WT, int dst_row0, int k0, LAS float* scr, int lane) {
#pragma unroll 8
    for (int i = 0; i < 32; ++i) { const int kk = 2 * i + (lane >> 5); scr[kk * 33 + (lane & 31)] = W[(size_t)(k0 + kk) * ldw + src_col0 + (lane & 31)]; }
    asm volatile("s_waitcnt lgkmcnt(0)" ::: "memory");
    const int c = lane & 7;
#pragma unroll
    for (int j = 0; j < 4; ++j) { const int n = (lane >> 3) + 8 * j; const LAS float* s = scr + (8 * c) * 33 + n;
        u32x4v o; o.x = pk2(s[0 * 33], s[1 * 33]); o.y = pk2(s[2 * 33], s[3 * 33]); o.z = pk2(s[4 * 33], s[5 * 33]); o.w = pk2(s[6 * 33], s[7 * 33]);
        *(u32x4v*)(WT + (size_t)(dst_row0 + n) * K + k0 + 8 * c) = o; }
    asm volatile("s_waitcnt lgkmcnt(0)" ::: "memory");
}

__device__ __forceinline__ void phase_prologue(const Args& a, LAS unsigned char* lds, int tid, int lane, int wave, int G) {
    unsigned char* ws = a.ws;
    float* mod = (float*)(ws + WS_MOD);
    for (int item = blockIdx.x; item < NMOD / 64; item += G) {
        LAS float* sc = (LAS float*)lds;
        LAS float* red = (LAS float*)(lds + 65536);
        const float* c = a.in[1];
        for (int i = tid; i < NB * DM; i += 512) { const int b = i >> 10, k = i & 1023; const float v = c[i]; sc[k * 16 + b] = v / (1.f + __expf(-v)); }
        __syncthreads();
        const float* w = a.in[2] + item * 64 + lane;
        float acc[16];
#pragma unroll
        for (int b = 0; b < 16; ++b) acc[b] = 0.f;
        const int k0 = wave * 128;
#pragma unroll 4
        for (int k = k0; k < k0 + 128; ++k) {
            const float wv = w[(size_t)k * NMOD];
            const LAS f32x4* s4 = (const LAS f32x4*)(sc + k * 16);
#pragma unroll
            for (int q = 0; q < 4; ++q) { const f32x4 s = s4[q]; acc[4 * q] += s.x * wv; acc[4 * q + 1] += s.y * wv; acc[4 * q + 2] += s.z * wv; acc[4 * q + 3] += s.w * wv; }
        }
#pragma unroll
        for (int b = 0; b < 16; ++b) red[(wave * 16 + b) * 64 + lane] = acc[b];
        __syncthreads();
        for (int o = tid; o < 1024; o += 512) { const int b = o >> 6, l = o & 63; float s = 0.f;
#pragma unroll
            for (int w8 = 0; w8 < 8; ++w8) s += red[(w8 * 16 + b) * 64 + l];
            mod[b * NMOD + item * 64 + l] = s + a.in[3][item * 64 + l]; }
        __syncthreads();
    }
    LAS float* scr = (LAS float*)(lds + wave * 16384);
    const int gw = blockIdx.x * 8 + wave, NGW = G * 8;
    bf16* WIN = (bf16*)(ws + WS_WIN); bf16* WSB = (bf16*)(ws + WS_WSB); bf16* WFX = (bf16*)(ws + WS_WFX); bf16* WOUT = (bf16*)(ws + WS_WOUT); bf16* WGU = (bf16*)(ws + WS_WGU); bf16* WDN = (bf16*)(ws + WS_WDN);
    constexpr int I0 = 16 * 96, I1 = 16 * 64, I2 = 8 * 32, I3 = 8 * 32, I4 = 16 * 32, I5 = 16 * 88, I6 = 16 * 88, I7 = 44 * 32;
    constexpr int NITEMS = I0 + I1 + I2 + I3 + I4 + I5 + I6 + I7;
    for (int it = gw; it < NITEMS; it += NGW) {
        int r = it;
        if (r < I0) { const int kb = r / 96, nb = r % 96; transpose_item(a.in[5], DINP, 1024, 32 * nb, WIN, 32 * nb, 64 * kb, scr, lane); continue; } r -= I0;
        if (r < I1) { const int kb = r / 64, nb = r % 64; transpose_item(a.in[5], DINP, 1024, 3080 + 32 * nb, WIN, 3072 + 32 * nb, 64 * kb, scr, lane); continue; } r -= I1;
        if (r < I2) { const int kb = r / 32, nb = r % 32; transpose_item(a.in[8], 1024, 512, 32 * nb, WSB, 32 * nb, 64 * kb, scr, lane); continue; } r -= I2;
        if (r < I3) { const int kb = r / 32, nb = r % 32; transpose_item(a.in[9], 1024, 512, 32 * nb, WFX, 32 * nb, 64 * kb, scr, lane); continue; } r -= I3;
        if (r < I4) { const int kb = r / 32, nb = r % 32; transpose_item(a.in[10], 1024, 1024, 32 * nb, WOUT, 32 * nb, 64 * kb, scr, lane); continue; } r -= I4;
        if (r < I5) { const int kb = r / 88, nb = r % 88, n0 = 32 * nb; transpose_item(a.in[12], DFF, 1024, n0, WGU, (n0 >> 7) * 256 + (n0 & 127), 64 * kb, scr, lane); continue; } r -= I5;
        if (r < I6) { const int kb = r / 88, nb = r % 88, n0 = 32 * nb; transpose_item(a.in[13], DFF, 1024, n0, WGU, (n0 >> 7) * 256 + 128 + (n0 & 127), 64 * kb, scr, lane); continue; } r -= I6;
        { const int kb = r / 32, nb = r % 32; transpose_item(a.in[14], 1024, DFF, 32 * nb, WDN, 32 * nb, 64 * kb, scr, lane); }
    }
}

template <int MODE>
__device__ __forceinline__ void norm_pass(const Args& a, LAS unsigned char* lds, int tid, int lane, int wave, int G) {
    unsigned char* ws = a.ws;
    const float* mod = (const float*)(ws + WS_MOD);
    const float* src = a.in[0];
    const bf16* srcb = MODE == 1 ? (const bf16*)(ws + WS_YSB) : (const bf16*)(ws + WS_H);
    const float* gvec = MODE == 0 ? a.in[4] : (MODE == 1 ? a.in[11] : a.in[15]);
    constexpr int SH = MODE == 0 ? 0 : 3 * DM, SC = MODE == 0 ? DM : 4 * DM;
    bf16* H = (bf16*)(ws + WS_H);
    float* LOGF = (float*)(ws + WS_LOGF);
    LAS float* wfL = (LAS float*)lds;
    if (MODE == 0) {
        for (int i = tid; i < 8192; i += 512) { const int jj = i >> 10, k = i & 1023; wfL[i] = a.in[5][(size_t)k * DINP + 3072 + jj]; }
        __syncthreads();
    }
    const int gw = blockIdx.x * 8 + wave, NGW = G * 8;
    for (int r0 = gw * 32; r0 < T; r0 += NGW * 32) {
        const int b = r0 >> 12;
        f32x4 gs[4], sh[4];
#pragma unroll
        for (int j = 0; j < 4; ++j) { const int col = 4 * lane + 256 * j; const f32x4 g4 = *(const f32x4*)(gvec + col);
            if (MODE < 2) { const f32x4 s4 = *(const f32x4*)(mod + b * NMOD + SC + col); sh[j] = *(const f32x4*)(mod + b * NMOD + SH + col); gs[j] = g4 * (1.f + s4); }
            else { gs[j] = g4; sh[j] = (f32x4){0.f, 0.f, 0.f, 0.f}; } }
        f32x4 vn[4];
#define NP_LOAD(dst, row_) do { if (MODE == 0) { const f32x4* xr_ = (const f32x4*)(src + (size_t)(row_) * DM) + lane; \
                _Pragma("unroll") for (int j = 0; j < 4; ++j) dst[j] = xr_[64 * j]; } \
            else { const u32x2v* xr_ = (const u32x2v*)(srcb + (size_t)(row_) * DM) + lane; \
                _Pragma("unroll") for (int j = 0; j < 4; ++j) { const u32x2v w_ = xr_[64 * j]; \
                    dst[j] = (f32x4){__uint_as_float(w_.x << 16), __uint_as_float(w_.x & 0xffff0000u), __uint_as_float(w_.y << 16), __uint_as_float(w_.y & 0xffff0000u)}; } } } while (0)
        NP_LOAD(vn, r0);
        for (int rr = 0; rr < 32; ++rr) {
            const size_t row = (size_t)r0 + rr;
            f32x4 v[4];
#pragma unroll
            for (int j = 0; j < 4; ++j) v[j] = vn[j];
            if (rr < 31) NP_LOAD(vn, row + 1);
            float ss = 0.f;
#pragma unroll
            for (int j = 0; j < 4; ++j) ss += (v[j].x * v[j].x + v[j].y * v[j].y) + (v[j].z * v[j].z + v[j].w * v[j].w);
            ss = wave_sum(ss);
            const float rstd = 1.0f / sqrtf(ss * (1.0f / DM) + RMS_EPS);
#pragma unroll
            for (int j = 0; j < 4; ++j) v[j] = v[j] * rstd * gs[j] + sh[j];
            if (MODE == 2) { f32x4* o = (f32x4*)(a.out + row * DM) + lane;
#pragma unroll
                for (int j = 0; j < 4; ++j) o[64 * j] = v[j]; }
            else { u32x2v* o = (u32x2v*)(H + row * DM) + lane;
#pragma unroll
                for (int j = 0; j < 4; ++j) { u32x2v w; w.x = pk2(v[j].x, v[j].y); w.y = pk2(v[j].z, v[j].w); o[64 * j] = w; } }
            if (MODE == 0) {
                float f[8];
#pragma unroll
                for (int jj = 0; jj < 8; ++jj) { float s = 0.f;
#pragma unroll
                    for (int j = 0; j < 4; ++j) { const f32x4 w4 = *(const LAS f32x4*)(wfL + jj * 1024 + 4 * lane + 256 * j); s += (v[j].x * w4.x + v[j].y * w4.y) + (v[j].z * w4.z + v[j].w * w4.w); }
                    f[jj] = s; }
                const bool h5 = (lane & 32) != 0, h4 = (lane & 16) != 0, h3 = (lane & 8) != 0;
#pragma unroll
                for (int i = 0; i < 4; ++i) { const float send = h5 ? f[i] : f[i + 4], keep = h5 ? f[i + 4] : f[i]; f[i] = keep + __shfl_xor(send, 32); }
#pragma unroll
                for (int i = 0; i < 2; ++i) { const float send = h4 ? f[i] : f[i + 2], keep = h4 ? f[i + 2] : f[i]; f[i] = keep + __shfl_xor(send, 16); }
                { const float send = h3 ? f[0] : f[1], keep = h3 ? f[1] : f[0]; f[0] = keep + __shfl_xor(send, 8); }
                f[0] += __shfl_xor(f[0], 4); f[0] += __shfl_xor(f[0], 2); f[0] += __shfl_xor(f[0], 1);
                if ((lane & 7) == 0) { const int jj = lane >> 3; const float val = f[0] + a.in[6][jj];
                    LOGF[((size_t)(b * 8 + jj) << 12) + (row & 4095)] = fminf(val, 0.f) - log1pf(__expf(-fabsf(val))); }
            }
        }
    }
}

__device__ __forceinline__ void scan_phase(const Args& a, LAS unsigned char* lds, int tid, int lane, int wave, int G) {
    const float* LOGF = (const float*)(a.ws + WS_LOGF); float* CUM = (float*)(a.ws + WS_CUM);
    LAS float* wt = (LAS float*)lds;
    for (int bh = blockIdx.x; bh < 128; bh += G) {
        const f32x4* src = (const f32x4*)(LOGF + (size_t)bh * SEQ + tid * 8);
        f32x4 a0 = src[0], a1 = src[1];
        a0.y += a0.x; a0.z += a0.y; a0.w += a0.z; a1.x += a0.w; a1.y += a1.x; a1.z += a1.y; a1.w += a1.z;
        const float tot = a1.w; float sc = tot;
#pragma unroll
        for (int o = 1; o < 64; o <<= 1) { const float n = __shfl_up(sc, o); if (lane >= o) sc += n; }
        if (lane == 63) wt[wave] = sc;
        __syncthreads();
        float off = sc - tot;
        for (int w8 = 0; w8 < wave; ++w8) off += wt[w8];
        a0 += off; a1 += off;
        f32x4* dst = (f32x4*)(CUM + (size_t)bh * SEQ + tid * 8);
        dst[0] = a0; dst[1] = a1;
        __syncthreads();
    }
}

__device__ __forceinline__ void dbg_dump(const Args& a, const bf16* src, int pitch, int col0, int tid, int G) {
    for (size_t i = (size_t)blockIdx.x * 512 + tid; i < (size_t)T * DM; i += (size_t)G * 512) { const size_t t = i >> 10; const int c = (int)(i & 1023);
        a.out[i] = __uint_as_float((unsigned)src[t * pitch + col0 + c] << 16); }
}
#define XB_TMO      128
#define XB_XCNT(j)  (256  + 64 * (j))
#define XB_XSUB(j)  (1280 + 64 * (j))
#define XB_XGEN(j)  (2304 + 64 * (j))
#define XB_TOP      3328
#define XB_TOPGEN   3392
#define XCD_BAR_WORDS 3456
#define XB_SPIN_CAP (1u << 18)

__device__ __forceinline__ unsigned xb_ld(unsigned* p)              { return __hip_atomic_load(p, __ATOMIC_RELAXED, __HIP_MEMORY_SCOPE_AGENT); }
__device__ __forceinline__ unsigned xb_add(unsigned* p, unsigned v) { return __hip_atomic_fetch_add(p, v, __ATOMIC_RELAXED, __HIP_MEMORY_SCOPE_AGENT); }
__device__ __forceinline__ unsigned xb_xcc_id() { return (unsigned)__builtin_amdgcn_s_getreg((3 << 11) | 20) & 0xFu; }
#define XB_SPIN(cond, bar) do { unsigned _sp = 0; while (cond) { __builtin_amdgcn_s_sleep(1); \
    if ((++_sp & 255u) == 0u) { if (xb_ld(&(bar)[XB_TMO])) break; if (_sp > XB_SPIN_CAP) { atomicAdd(&(bar)[XB_TMO], 1u); break; } } } } while (0)

struct XcdBarrier {
    unsigned* bar; unsigned x;
    volatile LAS unsigned* st;
};

__device__ __forceinline__ XcdBarrier xcd_barrier_post(unsigned* bar, volatile LAS unsigned* st) {
    XcdBarrier b; b.bar = bar; b.x = xb_xcc_id(); b.st = st;
    if (threadIdx.x == 0) (void)xb_add(&bar[XB_XCNT(b.x)], 1u);
    return b;
}
__device__ __forceinline__ void xcd_barrier_complete(unsigned* bar, unsigned x, unsigned& nloc, unsigned& nx) {
    const unsigned G = gridDim.x * gridDim.y * gridDim.z;
    unsigned sum, cnt, mine, sp = 0u;
    for (;;) {
        sum = 0u; cnt = 0u; mine = 0u;
#pragma unroll
        for (unsigned j = 0; j < 16; ++j) { const unsigned c = xb_ld(&bar[XB_XCNT(j)]); sum += c; cnt += (c > 0u) ? 1u : 0u; mine = (j == x) ? c : mine; }
        if (sum == G) break;
        __builtin_amdgcn_s_sleep(1);
        if ((++sp & 255u) == 0u) { if (xb_ld(&bar[XB_TMO])) break; if (sp > XB_SPIN_CAP) { atomicAdd(&bar[XB_TMO], 1u); break; } }
    }
    nloc = mine > 0u ? mine : 1u; nx = cnt > 0u ? cnt : 1u;
}

__device__ __forceinline__ void xcd_barrier(const XcdBarrier& b) {
    asm volatile("s_waitcnt vmcnt(0)" ::: "memory");
    __syncthreads();
    if (threadIdx.x == 0) {
        unsigned* bar = b.bar;
        __builtin_amdgcn_s_waitcnt(0);
        unsigned nloc = b.st[0], nx = b.st[1];
        if (nloc == 0u) { xcd_barrier_complete(bar, b.x, nloc, nx); b.st[0] = nloc; b.st[1] = nx; }
        const unsigned old = xb_add(&bar[XB_XSUB(b.x)], 1u);
        const unsigned gen = old / nloc;
        if (old + 1u == (gen + 1u) * nloc) {
            __builtin_amdgcn_fence(__ATOMIC_RELEASE, "agent");
            asm volatile("s_waitcnt vmcnt(0)" ::: "memory");
            const unsigned og = xb_add(&bar[XB_TOP], 1u);
            const unsigned tg = og / nx;
            if (og + 1u == (tg + 1u) * nx) xb_add(&bar[XB_TOPGEN], 1u);
            else XB_SPIN(xb_ld(&bar[XB_TOPGEN]) == tg, bar);
            __builtin_amdgcn_fence(__ATOMIC_ACQUIRE, "agent");
            xb_add(&bar[XB_XGEN(b.x)], 1u);
            asm volatile("s_waitcnt vmcnt(0)" ::: "memory");
        } else {
            XB_SPIN(xb_ld(&bar[XB_XGEN(b.x)]) == gen, bar);
            __builtin_amdgcn_fence(__ATOMIC_ACQUIRE, "agent");
            asm volatile("s_waitcnt vmcnt(0)" ::: "memory");
        }
    }
    __syncthreads();
}

__global__ void __launch_bounds__(512, 2) mega_fwd(Args a) {
    extern __shared__ __attribute__((aligned(16))) unsigned char lds_raw[];
    LAS unsigned char* lds = (LAS unsigned char*)lds_raw;
    cg::grid_group grid = cg::this_grid();
    const int tid = threadIdx.x, lane = tid & 63, wave = __builtin_amdgcn_readfirstlane(tid >> 6);
    const int G = gridDim.x, bx = blockIdx.x;
    unsigned char* ws = a.ws;
    const int lo = a.ph_lo, hi = a.ph_hi;
    volatile LAS unsigned* xst = (volatile LAS unsigned*)(lds + 131072 + 64);
    if (tid < 2) xst[tid] = 0u;
    __syncthreads();
    XcdBarrier xbar = xcd_barrier_post((unsigned*)ws, xst);
    if (a.ph_lo < 0) grid.sync();
#define IN(k) (lo <= (k) && (k) < hi)
#define SEAM(k) do { if (IN(k) && IN((k) + 1)) { xcd_barrier(xbar); } } while (0)
    bf16* H = (bf16*)(ws + WS_H); bf16* QKV = (bf16*)(ws + WS_QKV); bf16* GATES = (bf16*)(ws + WS_GATES); bf16* YSB = (bf16*)(ws + WS_YSB); bf16* YFX = (bf16*)(ws + WS_YFX); bf16* ACT = (bf16*)(ws + WS_ACT);
    const float* mod = (const float*)(ws + WS_MOD);

#ifndef DUP_P0
#define DUP_P0 1
#endif
    if (IN(0)) for (int rep_ = 0; rep_ < DUP_P0; ++rep_) phase_prologue(a, lds, tid, lane, wave, G);
    SEAM(0);
#ifndef DUP_P1
#define DUP_P1 1
#endif
    if (IN(1)) for (int rep_ = 0; rep_ < DUP_P1; ++rep_) norm_pass<0>(a, lds, tid, lane, wave, G);
    SEAM(1);
#if defined(DBG_DUMP) && DBG_DUMP == 1
    dbg_dump(a, H, 1024, 0, tid, G); return;
#endif
    if (IN(2)) {
        scan_phase(a, lds, tid, lane, wave, G);
        pg8::Gemm g{H, (const bf16*)(ws + WS_WIN), T, NIN, DM}; pg8::StaticOrder S; S.init(T, NIN, G, bx);
        pg8::EpiIn E{QKV, GATES, a.in[7], QSCALE};
        pg8::gemm_phase<pg8::EpiIn, pg8::StaticOrder, true, true>(lds, g, S, E);
    }
    SEAM(2);
#if defined(DBG_DUMP) && DBG_DUMP == 2
    dbg_dump(a, QKV, 3072, 0, tid, G); return;
#endif
#if defined(DBG_DUMP) && DBG_DUMP == 3
    dbg_dump(a, QKV, 3072, 2048, tid, G); return;
#endif
#if defined(DBG_DUMP) && DBG_DUMP == 4
    dbg_dump(a, GATES, 2048, 0, tid, G); return;
#endif
#ifndef DUP_ATT
#define DUP_ATT 1
#endif
    if (IN(3)) for (int rep_ = 0; rep_ < DUP_ATT; ++rep_) {
        const int vcu = (G % 8 == 0) ? (bx % 8) * (G / 8) + bx / 8 : bx;
        const float* CUM = (const float*)(ws + WS_CUM);
        for (int vc = vcu; vc < 256; vc += G) {
            const int bh = vc >> 1, half = vc & 1, b = bh >> 3, h = bh & 7;
            att::fox_kmax(b, h, QKV + 2048, lds);
#ifndef DUP_FX
#define DUP_FX 1
#endif
            for (int rf_ = 0; rf_ < DUP_FX; ++rf_)
            for (int i = 0; i < 4; ++i) { const int s = 2 * (i >> 1) + half, qb = (i & 1) ? 7 - s : s;
                att::fox_unit64(b, h, qb, QKV + 1536, QKV + 2048, QKV + 2560, CUM + (size_t)bh * SEQ, YFX, lds); }
#ifndef DUP_SB
#define DUP_SB 1
#endif
            for (int rs_ = 0; rs_ < DUP_SB; ++rs_)
            { LAS unsigned* ctr = (LAS unsigned*)(lds + 131072);
              __syncthreads();
              if (tid == 0) *ctr = 0u;
              __syncthreads();
              for (;;) {
                  unsigned idx = 0u;
                  if (lane == 0) idx = __hip_atomic_fetch_add(ctr, 1u, __ATOMIC_RELAXED, __HIP_MEMORY_SCOPE_WORKGROUP);
                  idx = (unsigned)__builtin_amdgcn_readfirstlane((int)idx);
                  if (idx >= 64u) break;
                  att::sb_wave_block(b, h, 127 - (2 * (int)idx + half), QKV, QKV + 512, QKV + 1024, YSB, lds + wave * 16384);
              }
              __syncthreads(); }
        }
    }
    SEAM(3);
    if (IN(4)) {
        pg8::Gemm g{YSB, (const bf16*)(ws + WS_WSB), T, DM, 512}; pg8::StaticOrder S; S.init(T, DM, G, bx);
        pg8::EpiBranch<true> E{H, GATES, 0};
        pg8::gemm_phase<pg8::EpiBranch<true>, pg8::StaticOrder, true, true>(lds, g, S, E);
    }
    if (IN(5)) {
        pg8::Gemm g{YFX, (const bf16*)(ws + WS_WFX), T, DM, 512}; pg8::StaticOrder S; S.init(T, DM, G, bx);
        pg8::EpiBranch<false> E{H, GATES, 1024};
        pg8::gemm_phase<pg8::EpiBranch<false>, pg8::StaticOrder, true, true>(lds, g, S, E);
    }
    SEAM(5);
#if defined(DBG_DUMP) && DBG_DUMP == 5
    dbg_dump(a, H, 1024, 0, tid, G); return;
#endif
    if (IN(6)) {
        pg8::Gemm g{H, (const bf16*)(ws + WS_WOUT), T, DM, DM}; pg8::StaticOrder S; S.init(T, DM, G, bx);
        pg8::EpiResidBf<false> E{a.in[0], nullptr, YSB, mod + 2 * DM};
        pg8::gemm_phase<pg8::EpiResidBf<false>, pg8::StaticOrder, true, true>(lds, g, S, E);
    }
    SEAM(6);
    if (IN(7)) norm_pass<1>(a, lds, tid, lane, wave, G);
    SEAM(7);
#ifndef DUP_P8
#define DUP_P8 1
#endif
    if (IN(8)) for (int rep_ = 0; rep_ < DUP_P8; ++rep_) {
        pg8::Gemm g{H, (const bf16*)(ws + WS_WGU), T, 2 * DFF, DM}; pg8::StaticOrder S; S.init(T, 2 * DFF, G, bx);
        pg8::EpiSwiglu E{ACT};
        pg8::gemm_phase<pg8::EpiSwiglu, pg8::StaticOrder, true, true>(lds, g, S, E);
    }
    SEAM(8);
    if (IN(9)) {
        pg8::Gemm g{ACT, (const bf16*)(ws + WS_WDN), T, DM, DFF}; pg8::StaticOrder S; S.init(T, DM, G, bx);
        pg8::EpiResidBf<true> E{nullptr, YSB, H, mod + 5 * DM};
        pg8::gemm_phase<pg8::EpiResidBf<true>, pg8::StaticOrder, true, true>(lds, g, S, E);
    }
    SEAM(9);
#ifdef DUP_XSYNC
    for (int rep_ = 0; rep_ < DUP_XSYNC; ++rep_) xcd_barrier(xbar);
#endif
#ifdef DUP_SYNC
    for (int rep_ = 0; rep_ < DUP_SYNC; ++rep_) { asm volatile("s_waitcnt vmcnt(0) lgkmcnt(0)" ::: "memory"); __syncthreads(); grid.sync(); asm volatile("s_waitcnt vmcnt(0)" ::: "memory"); __syncthreads(); }
#endif
    if (IN(10)) norm_pass<2>(a, lds, tid, lane, wave, G);
#undef IN
#undef SEAM
}

extern "C" void kernel_launch(void* const* d_in, const int* in_sizes, int n_in, void* d_out, int out_size, void* d_ws, size_t ws_size, hipStream_t stream) {
    static int grid = 0;
    if (grid == 0) {
        if (n_in != 16 || in_sizes[0] != T * DM || out_size != T * DM || ws_size < WS_END) { fprintf(stderr, "kernel_launch: unexpected shapes (n_in %d, in0 %d, out %d, ws %zu)\n", n_in, n_in > 0 ? in_sizes[0] : -1, out_size, ws_size); grid = -1; return; }
        int dev = 0, cus = 0, per_cu = 0;
        if (hipGetDevice(&dev) != hipSuccess || hipDeviceGetAttribute(&cus, hipDeviceAttributeMultiprocessorCount, dev) != hipSuccess) { grid = -1; return; }
        if (hipFuncSetAttribute((const void*)mega_fwd, hipFuncAttributeMaxDynamicSharedMemorySize, LDS_BYTES) != hipSuccess) { fprintf(stderr, "kernel_launch: hipFuncSetAttribute failed\n"); grid = -1; return; }
        if (hipOccupancyMaxActiveBlocksPerMultiprocessor(&per_cu, (const void*)mega_fwd, 512, LDS_BYTES) != hipSuccess || per_cu < 1) { fprintf(stderr, "kernel_launch: occupancy query says %d\n", per_cu); per_cu = 1; }
        (void)hipGetLastError();
        grid = cus * per_cu;
    }
    if (grid < 0) return;
    if (hipMemsetAsync(d_ws, 0, 16384, stream) != hipSuccess) { fprintf(stderr, "kernel_launch: hipMemsetAsync failed\n"); return; }
    Args a{};
    for (int i = 0; i < 16; ++i) a.in[i] = (const float*)d_in[i];
    a.out = (float*)d_out; a.ws = (unsigned char*)d_ws;
#ifndef MK_SPLIT
#define MK_SPLIT 0
#endif
    for (int p0 = 0; p0 < NPHASE; p0 += (MK_SPLIT ? 1 : NPHASE)) {
        a.ph_lo = p0; a.ph_hi = MK_SPLIT ? p0 + 1 : NPHASE;
        void* args[] = {&a};
        const hipError_t e = hipLaunchCooperativeKernel((const void*)mega_fwd, dim3(grid), dim3(512), args, LDS_BYTES, stream);
        if (e != hipSuccess) fprintf(stderr, "kernel_launch: cooperative launch failed: %s (grid %d)\n", hipGetErrorString(e), grid);
    }
}
```
